# Optimizing an MI355X kernel written in HIP

```python
import jax, jax.numpy as jnp
from jax import lax
import numpy as np

D_MODEL = 1024
BATCH = 8
SEQ = 4096
DEPTH = 1

HEAD_DIM = 64
ATT_WIDTH = D_MODEL // 2
N_ATT_HEADS = ATT_WIDTH // HEAD_DIM
DIL_PATTERNS = ((128, 1), (512, 4), (2048, 16))
POOL_WIDTH = D_MODEL - ATT_WIDTH
POOL_WINDOWS = (2, 4, 8, 16)
N_POOL_GROUPS = len(POOL_WINDOWS)
POOL_GROUP_DIM = POOL_WIDTH // N_POOL_GROUPS
IN_WIDTH = 3 * ATT_WIDTH + POOL_WIDTH
MIX_WIDTH = ATT_WIDTH + POOL_WIDTH
D_FF = ((8 * D_MODEL // 3 + 127) // 128) * 128
CONV_WIDTH = 3
PLE_DIM = 256
EPS = 1e-6

kernel_name = "hybrid_dilated_attn_multiscale_pool_block"


def _rmsnorm(t, g):
    tf = t.astype(jnp.float32)
    inv = lax.rsqrt(jnp.mean(tf * tf, axis=-1, keepdims=True) + EPS)
    return (tf * inv * g.astype(jnp.float32)).astype(t.dtype)


def _alibi_slopes(n_heads):
    return jnp.exp2(-8.0 * (jnp.arange(n_heads, dtype=jnp.float32) + 1.0) / n_heads)


def _dilated_branch(q, k, v, slopes, window, dil):
    B, S, H, Dh = q.shape
    span = window // dil
    unit = span * dil
    Sp = -(-S // unit) * unit
    L = Sp // dil
    nb = L // span
    pad = ((0, 0), (0, Sp - S), (0, 0), (0, 0))

    def blocks(t):
        return jnp.pad(t, pad).reshape(B, nb, span, dil, H, Dh)

    def with_prev(t):
        prev = jnp.pad(t, ((0, 0), (1, 0), (0, 0), (0, 0), (0, 0), (0, 0)))[:, :nb]
        return jnp.concatenate([prev, t], axis=2)

    qb = blocks(q)
    kk = with_prev(blocks(k))
    vv = with_prev(blocks(v))
    s = jnp.einsum('bnqrhd,bnkrhd->bnrhqk', qb, kk,
                   preferred_element_type=jnp.float32)
    qi = jnp.arange(span)[:, None]
    kj = jnp.arange(2 * span)[None, :]
    diff = qi + span - kj
    blk = jnp.arange(nb)[:, None, None]
    valid = (diff >= 0) & (diff <= span) & (blk * span - span + kj[None] >= 0)
    dist = (diff * dil).astype(jnp.float32)
    s = s - slopes[:, None, None] * dist
    s = jnp.where(valid[:, None, None], s, -jnp.inf)
    m = jnp.max(s, axis=-1, keepdims=True)
    e = jnp.exp(s - m)
    den = jnp.sum(e, axis=-1)
    o = jnp.einsum('bnrhqk,bnkrhd->bnqrhd', e, vv.astype(jnp.float32))
    den_t = jnp.transpose(den, (0, 1, 4, 2, 3))
    m_t = jnp.transpose(m[..., 0], (0, 1, 4, 2, 3))
    o = o / den_t[..., None]
    o = o.reshape(B, Sp, H, Dh)[:, :S]
    return o, m_t.reshape(B, Sp, H)[:, :S], den_t.reshape(B, Sp, H)[:, :S]


def _dilated_attention(q, k, v, slopes):
    outs, maxes, dens = [], [], []
    for window, dil in DIL_PATTERNS:
        o, m, d = _dilated_branch(q, k, v, slopes, window, dil)
        outs.append(o)
        maxes.append(m)
        dens.append(d)
    o = jnp.stack(outs)
    m = jnp.stack(maxes)
    d = jnp.stack(dens)
    w = d * jnp.exp(m - jnp.max(m, axis=0, keepdims=True))
    w = w / jnp.sum(w, axis=0, keepdims=True)
    return jnp.sum(w[..., None] * o, axis=0)


def _multiscale_pool(u, pool_w, pool_scale):
    B, S, _ = u.shape
    ug = u.astype(jnp.float32).reshape(B, S, N_POOL_GROUPS, POOL_GROUP_DIM)
    cs0 = jnp.pad(jnp.cumsum(ug, axis=1), ((0, 0), (1, 0), (0, 0), (0, 0)))
    upper = cs0[:, 1:]
    t = jnp.arange(S)
    diffs = []
    for g, w in enumerate(POOL_WINDOWS):
        lower = jnp.pad(cs0[:, :, g], ((0, 0), (w - 1, 0), (0, 0)))[:, :S]
        count = jnp.minimum(t + 1, w).astype(jnp.float32)[None, :, None]
        diffs.append((upper[:, :, g] - lower) / count - ug[:, :, g])
    dlt = jnp.stack(diffs, axis=2).astype(u.dtype)
    y = jnp.einsum('bsgc,gce->bsge', dlt, pool_w)
    y = y * pool_scale.reshape(N_POOL_GROUPS, POOL_GROUP_DIM)
    return y.reshape(B, S, POOL_WIDTH)


def _shift(t, s):
    if s == 0:
        return t
    return jnp.pad(t, ((0, 0), (s, 0), (0, 0)))[:, :t.shape[1]]


def _causal_dwconv(t, w, b):
    y = b
    for kk in range(CONV_WIDTH):
        y = y + w[kk] * _shift(t, CONV_WIDTH - 1 - kk)
    return y


def setup_inputs(seed: int = 0) -> dict:
    key = jax.random.key(seed)
    ks = jax.random.split(key, 20)
    f32 = jnp.float32

    def nrm(k, shape, scale):
        return jax.random.normal(k, shape, f32) * scale

    return {
        "x": nrm(ks[0], (BATCH, SEQ, D_MODEL), 1.0),
        "p": nrm(ks[1], (DEPTH, BATCH, SEQ, PLE_DIM), 1.0),
        "ln_mix": 1.0 + nrm(ks[2], (DEPTH, D_MODEL), 0.02),
        "w_in": nrm(ks[3], (DEPTH, D_MODEL, IN_WIDTH), D_MODEL ** -0.5),
        "pool_w": nrm(ks[4], (DEPTH, N_POOL_GROUPS, POOL_GROUP_DIM, POOL_GROUP_DIM), POOL_GROUP_DIM ** -0.5),
        "pool_scale": 1.0 + nrm(ks[5], (DEPTH, POOL_WIDTH), 0.1),
        "w_out": nrm(ks[6], (DEPTH, MIX_WIDTH, D_MODEL), MIX_WIDTH ** -0.5),
        "ln_ffn": 1.0 + nrm(ks[7], (DEPTH, D_MODEL), 0.02),
        "w_up": nrm(ks[8], (DEPTH, D_MODEL, 2 * D_FF), D_MODEL ** -0.5),
        "conv_w": nrm(ks[9], (DEPTH, CONV_WIDTH, 2 * D_FF), CONV_WIDTH ** -0.5),
        "conv_b": nrm(ks[10], (DEPTH, 2 * D_FF), 0.02),
        "w_down": nrm(ks[11], (DEPTH, D_FF, D_MODEL), D_FF ** -0.5),
        "ln_ple": 1.0 + nrm(ks[12], (DEPTH, D_MODEL), 0.02),
        "w_ple_gate": nrm(ks[13], (DEPTH, D_MODEL, D_MODEL), D_MODEL ** -0.5),
        "w_ple": nrm(ks[14], (DEPTH, PLE_DIM, D_MODEL), PLE_DIM ** -0.5),
        "ln_final": 1.0 + nrm(ks[15], (D_MODEL,), 0.02),
    }


def reference(x, p, ln_mix, w_in, pool_w, pool_scale, w_out, ln_ffn, w_up, conv_w, conv_b,
              w_down, ln_ple, w_ple_gate, w_ple, ln_final):
    B, S, _ = x.shape
    slopes = _alibi_slopes(N_ATT_HEADS)
    h = x
    for i in range(DEPTH):
        hn = _rmsnorm(h, ln_mix[i])
        z = hn @ w_in[i]
        q = z[..., :ATT_WIDTH].reshape(B, S, N_ATT_HEADS, HEAD_DIM) * (HEAD_DIM ** -0.5)
        k = z[..., ATT_WIDTH:2 * ATT_WIDTH].reshape(B, S, N_ATT_HEADS, HEAD_DIM)
        v = z[..., 2 * ATT_WIDTH:3 * ATT_WIDTH].reshape(B, S, N_ATT_HEADS, HEAD_DIM)
        u = z[..., 3 * ATT_WIDTH:]
        att = _dilated_attention(q, k, v, slopes).reshape(B, S, ATT_WIDTH).astype(h.dtype)
        pool = _multiscale_pool(u, pool_w[i], pool_scale[i]).astype(h.dtype)
        h = h + jnp.concatenate([att, pool], axis=-1) @ w_out[i]
        hn = _rmsnorm(h, ln_ffn[i])
        up = _causal_dwconv(hn @ w_up[i], conv_w[i], conv_b[i])
        gate, val = jnp.split(up, 2, axis=-1)
        h = h + (jax.nn.silu(gate) * val) @ w_down[i]
        g = jax.nn.sigmoid(_rmsnorm(h, ln_ple[i]) @ w_ple_gate[i])
        h = h + g * (p[i] @ w_ple[i])
    return _rmsnorm(h, ln_final)
```

```cpp
#include <hip/hip_runtime.h>
#include <hip/hip_cooperative_groups.h>
#include <cstdio>
#include <cstdint>
namespace cg = cooperative_groups;
namespace pg8 {
#define PG8_LAS __attribute__((address_space(3)))
typedef unsigned short bf16_t;
typedef short bf16x8 __attribute__((ext_vector_type(8)));
typedef float f32x4 __attribute__((ext_vector_type(4)));
typedef unsigned u32x4 __attribute__((ext_vector_type(4)));
constexpr int BM = 256, BK = 64, HALF = 128, HTB = HALF * BK * 2  , STAGE_BYTES = 8 * HTB, NXCD = 8, WGM = 8;

__host__ __device__ __forceinline__ int lds_byte(int r, int c) { const int st = (r >> 4) * 2 + (c >> 5), rr = r & 15, cc = c & 31, ob = rr * 64 + cc * 2; return st * 1024 + (ob ^ (((ob >> 9) & 1) << 5)); }
__host__ __device__ __forceinline__ void stage_rc(int b, int& R, int& C) { const int st = b / 1024, sb = b % 1024, swz = sb ^ (((sb >> 9) & 1) << 5); R = (st >> 1) * 16 + swz / 64; C = (st & 1) * 32 + (swz % 64) / 2; }
__host__ __device__ __forceinline__ int perm32(int rho) { const int n = rho >> 4, i = rho & 15; return 8 * (i >> 2) + 4 * n + (i & 3); }

struct Unit { int pm, pn; };
struct Gemm { const bf16_t* A; const bf16_t* Bt; int M, N, K; };

struct StaticOrder {
    int nM, nN, nwg, G, c;
    __host__ __device__ void init(int M, int N, int G_, int c_) { nM = M / BM; nN = N / BM; nwg = nM * nN; G = G_; c = c_; }
    __host__ __device__ bool next(int i, Unit& u) const {
        const long L = (long)i * G + c; if (L >= nwg) return false;
        int wgid = (int)L; { const int q = nwg / NXCD, r = nwg % NXCD, xcd = wgid % NXCD, off = wgid / NXCD; wgid = (xcd < r ? xcd * (q + 1) : r * (q + 1) + (xcd - r) * q) + off; }
        const int nig = WGM * nN, gid = wgid / nig, fm = gid * WGM, gsz = (nM - fm) < WGM ? (nM - fm) : WGM;
        u.pm = fm + ((wgid % nig) % gsz); u.pn = (wgid % nig) / gsz; return true;
    }
    __device__ __forceinline__ void a_ready(const Unit&) const {}
    __device__ __forceinline__ void done(const Unit&) const {}
};

__device__ __forceinline__ unsigned cvt_pk_bf16(float lo, float hi) { unsigned r; asm volatile("v_cvt_pk_bf16_f32 %0, %1, %2" : "=v"(r) : "v"(lo), "v"(hi)); return r; }
typedef unsigned u32x2 __attribute__((ext_vector_type(2)));
typedef float f32x2 __attribute__((ext_vector_type(2)));
__device__ __forceinline__ float bf_lo(unsigned w) { return __uint_as_float(w << 16); }
__device__ __forceinline__ float bf_hi(unsigned w) { return __uint_as_float(w & 0xffff0000u); }

template <bool ROWSCALE> struct EpiStoreBf16T {
    static constexpr bool PERM = true, AFTER_DRAIN = false, LINE = true;
    bf16_t* O; int ldc; const float* rs;
    __device__ __forceinline__ void operator()(f32x4 (&acc)[2][2][4][2], const Unit& u, int wr, int wc, int fr, int fq, PG8_LAS unsigned char*) const {
        const int row0 = u.pm * BM + wr * 64 + fr, col0 = u.pn * BM + wc * 64 + 8 * fq;
        float sc[2][4];
        if (ROWSCALE) {
#pragma unroll
            for (int ai = 0; ai < 2; ++ai)
#pragma unroll
                for (int m = 0; m < 4; ++m) sc[ai][m] = rs[row0 + ai * HALF + m * 16];
        }
#pragma unroll
        for (int ai = 0; ai < 2; ++ai)
#pragma unroll
            for (int m = 0; m < 4; ++m) { bf16_t* rowp = O + (size_t)(row0 + ai * HALF + m * 16) * ldc + col0;
#pragma unroll
                for (int bj = 0; bj < 2; ++bj) { f32x4 v0 = acc[ai][bj][m][0], v1 = acc[ai][bj][m][1];
                    if (ROWSCALE) { v0 = v0 * sc[ai][m]; v1 = v1 * sc[ai][m]; }
                    u32x4 w; w.x = cvt_pk_bf16(v0[0], v0[1]); w.y = cvt_pk_bf16(v0[2], v0[3]); w.z = cvt_pk_bf16(v1[0], v1[1]); w.w = cvt_pk_bf16(v1[2], v1[3]);
                    *(u32x4*)(rowp + bj * 32) = w; } }
    }
};
typedef EpiStoreBf16T<false> EpiStoreBf16;

template <bool BASE_F32> struct EpiRes {
    static constexpr bool PERM = true, AFTER_DRAIN = false, LINE = true;
    const float* base; bf16_t* hb; float* ss;
    __device__ __forceinline__ void operator()(f32x4 (&acc)[2][2][4][2], const Unit& u, int wr, int wc, int fr, int fq, PG8_LAS unsigned char*) const {
        const int col0 = u.pn * BM + wc * 64 + 8 * fq;
#pragma unroll
        for (int ai = 0; ai < 2; ++ai) {
            int r0 = u.pm * BM + ai * HALF + wr * 64 + fr; asm volatile("" : "+v"(r0));
            const size_t off0 = (size_t)r0 * 1024 + col0;
            f32x4 bq[4][2][2]; u32x4 bh[4][2];
#pragma unroll
            for (int m = 0; m < 4; ++m)
#pragma unroll
                for (int bj = 0; bj < 2; ++bj) { const size_t o = off0 + (size_t)m * 16 * 1024 + bj * 32;
                    if (BASE_F32) { bq[m][bj][0] = *(const f32x4*)(base + o); bq[m][bj][1] = *(const f32x4*)(base + o + 4); } else bh[m][bj] = *(const u32x4*)(hb + o); }
#pragma unroll
            for (int m = 0; m < 4; ++m) { float s = 0.f;
#pragma unroll
                for (int bj = 0; bj < 2; ++bj) { const size_t o = off0 + (size_t)m * 16 * 1024 + bj * 32; f32x4 b0, b1;
                    if (BASE_F32) { b0 = bq[m][bj][0]; b1 = bq[m][bj][1]; }
                    else { const u32x4 bw = bh[m][bj]; b0 = (f32x4){bf_lo(bw.x), bf_hi(bw.x), bf_lo(bw.y), bf_hi(bw.y)}; b1 = (f32x4){bf_lo(bw.z), bf_hi(bw.z), bf_lo(bw.w), bf_hi(bw.w)}; }
                    const f32x4 o0 = b0 + acc[ai][bj][m][0], o1 = b1 + acc[ai][bj][m][1];
                    u32x4 w; w.x = cvt_pk_bf16(o0[0], o0[1]); w.y = cvt_pk_bf16(o0[2], o0[3]); w.z = cvt_pk_bf16(o1[0], o1[1]); w.w = cvt_pk_bf16(o1[2], o1[3]);
                    *(u32x4*)(hb + o) = w;
                    s += ((o0[0] * o0[0] + o0[1] * o0[1]) + (o0[2] * o0[2] + o0[3] * o0[3])) + ((o1[0] * o1[0] + o1[1] * o1[1]) + (o1[2] * o1[2] + o1[3] * o1[3])); }
                s += __shfl_xor(s, 16); s += __shfl_xor(s, 32);
                if (fq == 0) (void)__hip_atomic_fetch_add(ss + r0 + m * 16, s, __ATOMIC_RELAXED, __HIP_MEMORY_SCOPE_AGENT); }
            asm volatile("" ::: "memory"); __builtin_amdgcn_sched_barrier(0);
        }
    }
};

__device__ __forceinline__ float inv_from_ss(float t) { return __builtin_amdgcn_rsqf(t * (1.0f / 1024.0f) + 1e-6f); }
__device__ __forceinline__ float sigmoidf_(float x) { return __builtin_amdgcn_rcpf(1.0f + __builtin_amdgcn_exp2f(-1.4426950408889634f * x)); }

struct EpiGate {
    static constexpr bool PERM = true, AFTER_DRAIN = false, LINE = true;
    const float* ss_in; const bf16_t* E; const bf16_t* hb; bf16_t* out;
    __device__ __forceinline__ void operator()(f32x4 (&acc)[2][2][4][2], const Unit& u, int wr, int wc, int fr, int fq, PG8_LAS unsigned char*) const {
        const int col0 = u.pn * BM + wc * 64 + 8 * fq;
#pragma unroll
        for (int ai = 0; ai < 2; ++ai) {
            int r0 = u.pm * BM + ai * HALF + wr * 64 + fr; asm volatile("" : "+v"(r0));
            const size_t off0 = (size_t)r0 * 1024 + col0;
            u32x4 hv[4][2], ev[4][2]; float sq[4];
#pragma unroll
            for (int m = 0; m < 4; ++m) { sq[m] = ss_in[r0 + m * 16];
#pragma unroll
                for (int bj = 0; bj < 2; ++bj) { const size_t o = off0 + (size_t)m * 16 * 1024 + bj * 32; hv[m][bj] = *(const u32x4*)(hb + o); ev[m][bj] = *(const u32x4*)(E + o); } }
#pragma unroll
            for (int m = 0; m < 4; ++m) { const float inv = inv_from_ss(sq[m]);
#pragma unroll
                for (int bj = 0; bj < 2; ++bj) { const size_t o = off0 + (size_t)m * 16 * 1024 + bj * 32; const u32x4 h2 = hv[m][bj], e2 = ev[m][bj];
                    const f32x4 a0 = acc[ai][bj][m][0] * inv, a1 = acc[ai][bj][m][1] * inv; float ov[8];
                    const unsigned hw[4] = {h2.x, h2.y, h2.z, h2.w}, ew[4] = {e2.x, e2.y, e2.z, e2.w};
#pragma unroll
                    for (int k = 0; k < 4; ++k) { const f32x2 av = (k < 2) ? (f32x2){a0[2 * k], a0[2 * k + 1]} : (f32x2){a1[2 * k - 4], a1[2 * k - 3]};
                        const f32x2 t = av * (-1.4426950408889634f); f32x2 d; d.x = __builtin_amdgcn_exp2f(t.x); d.y = __builtin_amdgcn_exp2f(t.y); d = d + 1.0f;
                        f32x2 sg; sg.x = __builtin_amdgcn_rcpf(d.x); sg.y = __builtin_amdgcn_rcpf(d.y);
                        const f32x2 hh = (f32x2){bf_lo(hw[k]), bf_hi(hw[k])}, ee = (f32x2){bf_lo(ew[k]), bf_hi(ew[k])}; const f32x2 r = hh + sg * ee; ov[2 * k] = r.x; ov[2 * k + 1] = r.y; }
                    u32x4 w; w.x = cvt_pk_bf16(ov[0], ov[1]); w.y = cvt_pk_bf16(ov[2], ov[3]); w.z = cvt_pk_bf16(ov[4], ov[5]); w.w = cvt_pk_bf16(ov[6], ov[7]);
                    *(u32x4*)(out + o) = w; } }
            asm volatile("" ::: "memory"); __builtin_amdgcn_sched_barrier(0);
        }
    }
};

#define DPPR(src_, ctrl_) __uint_as_float((unsigned)__builtin_amdgcn_update_dpp(0, (int)__float_as_uint(src_), ctrl_, 0xf, 0xf, true))
#define DPPF(old_, src_, ctrl_) __uint_as_float((unsigned)__builtin_amdgcn_update_dpp((int)__float_as_uint(old_), (int)__float_as_uint(src_), ctrl_, 0xf, 0xf, false))
struct EpiConv {
    static constexpr bool PERM = true, AFTER_DRAIN = false;
    const float* ss_in; const float* cw; const float* cb; bf16_t* act; float* halo;
    __device__ __forceinline__ void operator()(f32x4 (&acc)[2][2][4][2], const Unit& u, int wr, int wc, int fr_, int fq_, PG8_LAS unsigned char* lds) const {
        int fr = fr_, fq = fq_; asm volatile("" : "+v"(fr), "+v"(fq));
        PG8_LAS float* X = (PG8_LAS float*)(lds + 131072);
        f32x4 cA[2][4];
#pragma unroll
        for (int bj = 0; bj < 2; ++bj) { const int c = bj * 2816 + u.pn * 128 + wc * 32 + 8 * fq; cA[bj][0] = *(const f32x4*)(cw + c); cA[bj][1] = *(const f32x4*)(cw + 5632 + c); cA[bj][2] = *(const f32x4*)(cw + 2 * 5632 + c); cA[bj][3] = *(const f32x4*)(cb + c); }
        { float sq[2][4];
#pragma unroll
          for (int ai = 0; ai < 2; ++ai)
#pragma unroll
              for (int m = 0; m < 4; ++m) sq[ai][m] = ss_in[u.pm * BM + ai * HALF + wr * 64 + m * 16 + fr];
#pragma unroll
          for (int ai = 0; ai < 2; ++ai)
#pragma unroll
              for (int m = 0; m < 4; ++m) { const float inv = inv_from_ss(sq[ai][m]);
#pragma unroll
                  for (int bj = 0; bj < 2; ++bj)
#pragma unroll
                      for (int n = 0; n < 2; ++n) acc[ai][bj][m][n] = acc[ai][bj][m][n] * inv; }
          asm volatile("" ::: "memory"); __builtin_amdgcn_sched_barrier(0); }
        if (fr >= 14) {
#pragma unroll
            for (int ai = 0; ai < 2; ++ai) { const int xb = (((((wr * 2 + ai) * 4 + wc) * 2 + (fr - 14)) * 4) + fq) * 16;
#pragma unroll
                for (int bj = 0; bj < 2; ++bj)
#pragma unroll
                    for (int n = 0; n < 2; ++n) *(PG8_LAS f32x4*)(X + xb + bj * 8 + n * 4) = acc[ai][bj][3][n]; }
            if (wr == 1) { float* hp = halo + ((size_t)(u.pm * 4 + 2 + (fr - 14)) * 22 + u.pn) * 256 + wc * 32 + 8 * fq;
#pragma unroll
                for (int bj = 0; bj < 2; ++bj)
#pragma unroll
                    for (int n = 0; n < 2; ++n) *(f32x4*)(hp + bj * 128 + 4 * n) = acc[1][bj][3][n]; }
        }
        if (fr < 2 && wr == 0) { float* hp = halo + ((size_t)(u.pm * 4 + fr) * 22 + u.pn) * 256 + wc * 32 + 8 * fq;
#pragma unroll
            for (int bj = 0; bj < 2; ++bj)
#pragma unroll
                for (int n = 0; n < 2; ++n) *(f32x4*)(hp + bj * 128 + 4 * n) = acc[0][bj][0][n]; }
        asm volatile("s_waitcnt lgkmcnt(0)" ::: "memory"); __builtin_amdgcn_s_barrier(); asm volatile("" ::: "memory");
        const int pwr = wr ^ 1;
        u32x2 stash[2][4];
        auto grp = [&](const int n, const int ai, const f32x4 (&C)[2][4]) __attribute__((always_inline)) {
            const int gc = u.pn * 128 + wc * 32 + 8 * fq + 4 * n;
#pragma unroll
            for (int m = 0; m < 4; ++m) {
                int r = u.pm * BM + ai * HALF + wr * 64 + m * 16 + fr; asm volatile("" : "+v"(r));
                f32x4 y[2];
#pragma unroll
                for (int bj = 0; bj < 2; ++bj) {
                    const f32x4 U = acc[ai][bj][m][n]; f32x4 t1, t2;
                    if (m == 0) {
                        if (ai == 0 && wr == 0) { t1 = (f32x4){0.f, 0.f, 0.f, 0.f}; t2 = t1; }
                        else { const int pai = (wr == 1) ? ai : 0; const int xb = ((((pwr * 2 + pai) * 4 + wc) * 2) * 4 + fq) * 16 + bj * 8 + n * 4;
                            t1 = *(const PG8_LAS f32x4*)(X + xb + 64); t2 = *(const PG8_LAS f32x4*)(X + xb + (fr == 0 ? 0 : 64)); }
                    } else { const f32x4 Up = acc[ai][bj][m - 1][n];
#pragma unroll
                        for (int e = 0; e < 4; ++e) { t1[e] = DPPR(Up[e], 0x121); t2[e] = DPPR(Up[e], 0x122); } }
                    f32x4 P1, P2;
#pragma unroll
                    for (int e = 0; e < 4; ++e) { P1[e] = DPPF(t1[e], U[e], 0x111); P2[e] = DPPF(t2[e], U[e], 0x112); }
                    y[bj] = C[bj][0] * P2 + C[bj][1] * P1 + C[bj][2] * U + C[bj][3];
                    __builtin_amdgcn_sched_barrier(0);
                }
                f32x4 a;
#pragma unroll
                for (int e = 0; e < 4; e += 2) { const f32x2 gt = (f32x2){y[0][e], y[0][e + 1]}, vl = (f32x2){y[1][e], y[1][e + 1]}; const f32x2 t = gt * (-1.4426950408889634f);
                    f32x2 d; d.x = __builtin_amdgcn_exp2f(t.x); d.y = __builtin_amdgcn_exp2f(t.y); d = d + 1.0f; f32x2 r; r.x = __builtin_amdgcn_rcpf(d.x); r.y = __builtin_amdgcn_rcpf(d.y);
                    const f32x2 o2 = (gt * vl) * r; a[e] = o2.x; a[e + 1] = o2.y; }
                u32x2 w; w.x = cvt_pk_bf16(a[0], a[1]); w.y = cvt_pk_bf16(a[2], a[3]);
                if (n == 0) stash[ai][m] = w;
                else { u32x4 w16; w16.x = stash[ai][m].x; w16.y = stash[ai][m].y; w16.z = w.x; w16.w = w.y; *(u32x4*)(act + (size_t)r * 2816 + gc - 4) = w16; }
                __builtin_amdgcn_sched_barrier(0);
            }
        };
        grp(0, 0, cA);
        f32x4 cB[2][4];
#pragma unroll
        for (int bj = 0; bj < 2; ++bj) { const int c = bj * 2816 + u.pn * 128 + wc * 32 + 8 * fq + 4; cB[bj][0] = *(const f32x4*)(cw + c); cB[bj][1] = *(const f32x4*)(cw + 5632 + c); cB[bj][2] = *(const f32x4*)(cw + 2 * 5632 + c); cB[bj][3] = *(const f32x4*)(cb + c); }
        grp(0, 1, cA);
        grp(1, 0, cB);
        grp(1, 1, cB);
    }
};
template <class E, class = void> struct EpiLine { static constexpr bool value = false; };
template <class E> struct EpiLine<E, decltype((void)E::LINE)> { static constexpr bool value = E::LINE; };
template <class Epi, class Sched, bool ALIGN_EPI = false, bool SP2 = false>
__device__ __forceinline__ void gemm_phase(PG8_LAS unsigned char* lds, const Gemm g, const Sched& S, const Epi& E) {
    int tid_ = threadIdx.x; asm volatile("" : "+v"(tid_));
    const int tid = tid_, wid = __builtin_amdgcn_readfirstlane(tid >> 6), lane = tid & 63, wr = wid >> 2, wc = wid & 3, fr = lane & 15, fq = lane >> 4;
    const int K = g.K, nt = K / BK;
    unsigned voffA[2], voffB[2];
#pragma unroll
    for (int i = 0; i < 2; ++i) { int R, C; stage_rc(tid * 16 + i * 8192, R, C); const int Rb = EpiLine<Epi>::value ? (64 * (R >> 5) + perm32(R & 31)) : (Epi::PERM ? ((R & ~31) + perm32(R & 31)) : R);
        voffA[i] = (unsigned)(R * K + C) * 2u; voffB[i] = (unsigned)(Rb * K + C) * 2u; }
    const size_t kstep = (size_t)(BK * 2);
    const size_t hstep = (size_t)HALF * K * 2;
    const size_t tstep = 2 * hstep;
    const size_t hstepB = EpiLine<Epi>::value ? (size_t)32 * K * 2 : hstep;
    const unsigned ldsw = (unsigned)wid * 1024u;
    const int aoff = lds_byte(wr * 64 + fr, fq * 8), boff = lds_byte(wc * 32 + fr, fq * 8);
#define PG8_SA(b, h) (((b) * 2 + (h)) * HTB)
#define PG8_SB(b, h) ((4 + (b) * 2 + (h)) * HTB)
#define PG8_STAGE(bufoff, gbase, voff) do { _Pragma("unroll") for (int _i = 0; _i < 2; ++_i) \
        __builtin_amdgcn_global_load_lds((const unsigned*)((const char*)(gbase) + (voff)[_i]), (PG8_LAS unsigned*)(lds + (bufoff) + ldsw + _i * 8192), 16, 0, 0); } while (0)
#define PG8_LDA(dst, b, h) do { _Pragma("unroll") for (int m = 0; m < 4; ++m) _Pragma("unroll") for (int k = 0; k < 2; ++k) dst[m][k] = *(const PG8_LAS bf16x8*)(lds + PG8_SA(b, h) + aoff + m * 2048 + k * 1024); } while (0)
#define PG8_LDB(dst, b, h) do { _Pragma("unroll") for (int n = 0; n < 2; ++n) _Pragma("unroll") for (int k = 0; k < 2; ++k) dst[n][k] = *(const PG8_LAS bf16x8*)(lds + PG8_SB(b, h) + boff + n * 2048 + k * 1024); } while (0)
#define PG8_MMA(ai, bj, At, Bt) do { __builtin_amdgcn_s_setprio(1); _Pragma("unroll") for (int m = 0; m < 4; ++m) _Pragma("unroll") for (int n = 0; n < 2; ++n) _Pragma("unroll") for (int k = 0; k < 2; ++k) \
        acc[ai][bj][m][n] = __builtin_amdgcn_mfma_f32_16x16x32_bf16(Bt[n][k], At[m][k], acc[ai][bj][m][n], 0, 0, 0); __builtin_amdgcn_s_setprio(0); } while (0)
#define PG8_WAIT_V(n) asm volatile("s_waitcnt vmcnt(" #n ")" ::: "memory")
#define PG8_WAIT_L(n) asm volatile("s_waitcnt lgkmcnt(" #n ")" ::: "memory")
#define PG8_BAR __builtin_amdgcn_s_barrier()
#define PG8_SCHED __builtin_amdgcn_sched_barrier(0)
    Unit cur, nxt; int ui = 0;
    if (!S.next(0, cur)) return;
    f32x4 acc[2][2][4][2];
#pragma unroll
    for (int a = 0; a < 2; ++a)
#pragma unroll
        for (int b = 0; b < 2; ++b)
#pragma unroll
            for (int m = 0; m < 4; ++m)
#pragma unroll
                for (int n = 0; n < 2; ++n) acc[a][b][m][n] = (f32x4){0.f, 0.f, 0.f, 0.f};
    bf16x8 At[4][2], B0[2][2], B1[2][2];
    const char* cA = (const char*)g.A + (size_t)cur.pm * tstep; const char* cB = (const char*)g.Bt + (size_t)cur.pn * tstep;
    S.a_ready(cur);
    if constexpr (SP2) {
        PG8_STAGE(PG8_SB(0, 0), cB, voffB); PG8_STAGE(PG8_SB(0, 1), cB + hstepB, voffB); PG8_STAGE(PG8_SA(0, 0), cA, voffA); PG8_STAGE(PG8_SA(0, 1), cA + hstep, voffA);
        if (wr == 1) PG8_BAR;
        PG8_WAIT_V(2); PG8_BAR;
        PG8_STAGE(PG8_SB(1, 0), cB + kstep, voffB); PG8_STAGE(PG8_SA(1, 0), cA + kstep, voffA); PG8_STAGE(PG8_SB(1, 1), cB + hstepB + kstep, voffB);
        PG8_WAIT_V(6); PG8_BAR;
    } else {
        PG8_STAGE(PG8_SB(0, 0), cB, voffB); PG8_STAGE(PG8_SA(0, 0), cA, voffA); PG8_STAGE(PG8_SB(0, 1), cB + hstepB, voffB); PG8_STAGE(PG8_SA(0, 1), cA + hstep, voffA);
        if (wr == 1) PG8_BAR;
        PG8_WAIT_V(4); PG8_BAR;
        PG8_STAGE(PG8_SB(1, 0), cB + kstep, voffB); PG8_STAGE(PG8_SA(1, 0), cA + kstep, voffA); PG8_STAGE(PG8_SB(1, 1), cB + hstepB + kstep, voffB);
        PG8_WAIT_V(6); PG8_BAR;
    }
    for (;;) {
        const bool has_next = S.next(ui + 1, nxt);
        const char* nA = has_next ? (const char*)g.A + (size_t)nxt.pm * tstep : cA; const char* nB = has_next ? (const char*)g.Bt + (size_t)nxt.pn * tstep : cB;
        for (int t = 0; t < nt; t += 2) {
            const bool last = (t == nt - 2);
            const char* a1 = cA + (size_t)(t + 1) * kstep;
            const char* a2 = last ? nA : cA + (size_t)(t + 2) * kstep; const char* b2 = last ? nB : cB + (size_t)(t + 2) * kstep;
            const char* a3 = a2 + kstep; const char* b3 = b2 + kstep;
            if (last && has_next) S.a_ready(nxt);
            if constexpr (SP2) {
            PG8_LDB(B0, 0, 0); PG8_LDB(B1, 0, 1); PG8_SCHED; PG8_LDA(At, 0, 0); PG8_STAGE(PG8_SA(1, 1), a1 + hstep, voffA);
            PG8_WAIT_V(8); PG8_WAIT_L(0); PG8_BAR; PG8_MMA(0, 0, At, B0); PG8_MMA(0, 1, At, B1); PG8_BAR; PG8_SCHED;
            PG8_LDA(At, 0, 1); PG8_STAGE(PG8_SB(0, 0), b2, voffB); PG8_STAGE(PG8_SB(0, 1), b2 + hstepB, voffB); PG8_STAGE(PG8_SA(0, 0), a2, voffA);
            PG8_WAIT_V(8); PG8_WAIT_L(0); PG8_BAR; PG8_MMA(1, 0, At, B0); PG8_MMA(1, 1, At, B1); PG8_BAR; PG8_SCHED;
            PG8_LDB(B0, 1, 0); PG8_LDB(B1, 1, 1); PG8_SCHED; PG8_LDA(At, 1, 0); PG8_STAGE(PG8_SA(0, 1), a2 + hstep, voffA);
            PG8_WAIT_V(8); PG8_WAIT_L(0); PG8_BAR; PG8_MMA(0, 0, At, B0); PG8_MMA(0, 1, At, B1); PG8_BAR; PG8_SCHED;
            PG8_LDA(At, 1, 1); PG8_STAGE(PG8_SB(1, 0), b3, voffB); PG8_STAGE(PG8_SB(1, 1), b3 + hstepB, voffB); PG8_STAGE(PG8_SA(1, 0), a3, voffA);
            PG8_WAIT_V(8); PG8_WAIT_L(0); PG8_BAR; PG8_MMA(1, 0, At, B0); PG8_MMA(1, 1, At, B1); PG8_BAR; PG8_SCHED;
            } else {
            PG8_LDB(B0, 0, 0); PG8_SCHED; PG8_LDA(At, 0, 0); PG8_STAGE(PG8_SA(1, 1), a1 + hstep, voffA);
            PG8_WAIT_L(8); PG8_BAR; PG8_WAIT_L(0); PG8_MMA(0, 0, At, B0); PG8_BAR; PG8_SCHED;
            PG8_LDB(B1, 0, 1); PG8_STAGE(PG8_SB(0, 0), b2, voffB);
            PG8_BAR; PG8_WAIT_L(0); PG8_MMA(0, 1, At, B1); PG8_BAR;
            PG8_LDA(At, 0, 1); PG8_STAGE(PG8_SA(0, 0), a2, voffA);
            PG8_BAR; PG8_WAIT_L(0); PG8_MMA(1, 0, At, B0); PG8_BAR; PG8_SCHED;
            PG8_STAGE(PG8_SB(0, 1), b2 + hstepB, voffB);
            PG8_WAIT_V(6); PG8_BAR; PG8_MMA(1, 1, At, B1); PG8_BAR;
            PG8_LDB(B0, 1, 0); PG8_SCHED; PG8_LDA(At, 1, 0); PG8_STAGE(PG8_SA(0, 1), a2 + hstep, voffA);
            PG8_WAIT_L(8); PG8_BAR; PG8_WAIT_L(0); PG8_MMA(0, 0, At, B0); PG8_BAR; PG8_SCHED;
            PG8_LDB(B1, 1, 1); PG8_STAGE(PG8_SB(1, 0), b3, voffB);
            PG8_BAR; PG8_WAIT_L(0); PG8_MMA(0, 1, At, B1); PG8_BAR;
            PG8_LDA(At, 1, 1); PG8_STAGE(PG8_SA(1, 0), a3, voffA);
            PG8_BAR; PG8_WAIT_L(0); PG8_MMA(1, 0, At, B0); PG8_BAR; PG8_SCHED;
            PG8_STAGE(PG8_SB(1, 1), b3 + hstepB, voffB);
            PG8_WAIT_V(6); PG8_BAR; PG8_MMA(1, 1, At, B1); PG8_BAR;
            }
        }
        if constexpr (ALIGN_EPI) { if (wr == 0) PG8_BAR; }
        if constexpr (!Epi::AFTER_DRAIN) { E(acc, cur, wr, wc, fr, fq, lds); S.done(cur); }
        if (!has_next) break;
#pragma unroll
        for (int a = 0; a < 2; ++a)
#pragma unroll
            for (int b = 0; b < 2; ++b)
#pragma unroll
                for (int m = 0; m < 4; ++m)
#pragma unroll
                    for (int n = 0; n < 2; ++n) acc[a][b][m][n] = (f32x4){0.f, 0.f, 0.f, 0.f};
        cur = nxt; cA = nA; cB = nB; ++ui;
        if constexpr (ALIGN_EPI) { if (wr == 1) PG8_BAR; }
    }
    PG8_WAIT_V(0);
    if constexpr (!ALIGN_EPI) { if (wr == 0) PG8_BAR; }
    PG8_BAR;
    if constexpr (Epi::AFTER_DRAIN) { E.fused(acc, cur, wr, wc, fr, fq, lds, wid, lane); S.done(cur); }
#undef PG8_SA
#undef PG8_SB
#undef PG8_STAGE
#undef PG8_LDA
#undef PG8_LDB
#undef PG8_MMA
#undef PG8_WAIT_V
#undef PG8_WAIT_L
#undef PG8_BAR
#undef PG8_SCHED
}
}
constexpr int NB = 8, SEQ = 4096, MT = NB * SEQ, DM = 1024, NZ = 2048, FF = 2816, NUP = 5632, PLE = 256;
constexpr int NWAVES = 8;
constexpr size_t MiB = 1u << 20;
constexpr size_t WS_WIN = 1 * MiB, WS_WO = 5 * MiB, WS_WUP = 7 * MiB, WS_WDN = 19 * MiB, WS_WG = 25 * MiB, WS_WPLE = 27 * MiB;
constexpr size_t WS_XN = 32 * MiB;
constexpr size_t WS_PB = 96 * MiB;
constexpr size_t WS_E = 112 * MiB;
constexpr size_t WS_Z = 176 * MiB;
constexpr size_t WS_OP = 304 * MiB;
constexpr size_t WS_ML = 400 * MiB;
constexpr size_t WS_MIX = 406 * MiB;
constexpr size_t WS_HALO = 470 * MiB;
constexpr size_t WS_SS1 = 482 * MiB, WS_SS2 = WS_SS1 + (size_t)MT * 4, WS_RI = WS_SS2 + (size_t)MT * 4;
constexpr size_t WS_ACT = 176 * MiB;
constexpr size_t WS_END = 488 * MiB;
static_assert(WS_ACT + (size_t)MT * FF * 2 <= WS_MIX, "act overlay");
constexpr int LDS_BYTES = 147456;
#define LAS __attribute__((address_space(3)))
typedef unsigned short bf16;
typedef unsigned v4u __attribute__((ext_vector_type(4)));
typedef unsigned v2u __attribute__((ext_vector_type(2)));
typedef float f32x4 __attribute__((ext_vector_type(4)));
typedef float f32x16 __attribute__((ext_vector_type(16)));
typedef short bf16x8 __attribute__((ext_vector_type(8)));
#define LDS_WAIT() asm volatile("s_waitcnt lgkmcnt(0)" ::: "memory")
__device__ __forceinline__ unsigned pk2(float lo, float hi) { return pg8::cvt_pk_bf16(lo, hi); }
__device__ __forceinline__ float blo(unsigned w) { return __uint_as_float(w << 16); }
__device__ __forceinline__ float bhi(unsigned w) { return __uint_as_float(w & 0xffff0000u); }
__device__ __forceinline__ float wave_sum(float v) {
#pragma unroll
    for (int o = 1; o < 64; o <<= 1) v += __shfl_xor(v, o);
    return v;
}

__device__ __forceinline__ void tr_fill(const float* W, int ldw, int k0, int c0, const float* kscale, float mul, LAS float* scr, int lane) {
    const int c4 = (lane & 7) * 4;
    f32x4 v[8];
#pragma unroll
    for (int i = 0; i < 8; ++i) v[i] = __builtin_nontemporal_load((const f32x4*)(W + (size_t)(k0 + (lane >> 3) + 8 * i) * ldw + c0 + c4));
#pragma unroll
    for (int i = 0; i < 8; ++i) { const int kk = (lane >> 3) + 8 * i; const float sc = kscale ? kscale[k0 + kk] * mul : mul;
        scr[kk * 33 + c4 + 0] = v[i].x * sc; scr[kk * 33 + c4 + 1] = v[i].y * sc; scr[kk * 33 + c4 + 2] = v[i].z * sc; scr[kk * 33 + c4 + 3] = v[i].w * sc; }
    LDS_WAIT(); asm volatile("" ::: "memory");
}
__device__ __forceinline__ void tr_write(bf16* WT, int ldt, int row0, int kd0, LAS float* scr, int lane) {
    const int c = lane & 7;
#pragma unroll
    for (int j = 0; j < 4; ++j) { const int n = (lane >> 3) + 8 * j; const LAS float* s = scr + (8 * c) * 33 + n;
        v4u o; o.x = pk2(s[0 * 33], s[1 * 33]); o.y = pk2(s[2 * 33], s[3 * 33]); o.z = pk2(s[4 * 33], s[5 * 33]); o.w = pk2(s[6 * 33], s[7 * 33]);
        *(v4u*)(WT + (size_t)(row0 + n) * ldt + kd0 + 8 * c) = o; }
    LDS_WAIT(); asm volatile("" ::: "memory");
}
__device__ __forceinline__ void weff_item(const float* pool_w, const float* pool_scale, const float* w_out, bf16* WT, int g, int c8, int n0, int lane) {
    const int n = lane & 31, half = lane >> 5;
    float acc[4] = {0.f, 0.f, 0.f, 0.f};
    const float* pw = pool_w + ((size_t)(g * 128 + c8 * 8 + half * 4)) * 128;
    const float* wo = w_out + (size_t)(512 + g * 128) * 1024 + n0 + n;
    const float* ps = pool_scale + g * 128;
#pragma unroll 4
    for (int e = 0; e < 128; e += 4) {
        const f32x4 sc = *(const f32x4*)(ps + e);
        const float w0 = wo[(size_t)(e + 0) * 1024] * sc.x, w1 = wo[(size_t)(e + 1) * 1024] * sc.y, w2 = wo[(size_t)(e + 2) * 1024] * sc.z, w3 = wo[(size_t)(e + 3) * 1024] * sc.w;
#pragma unroll
        for (int i = 0; i < 4; ++i) { const f32x4 p = *(const f32x4*)(pw + (size_t)i * 128 + e); acc[i] += (p.x * w0 + p.y * w1) + (p.z * w2 + p.w * w3); }
    }
    v2u o; o.x = pk2(acc[0], acc[1]); o.y = pk2(acc[2], acc[3]);
    *(v2u*)(WT + (size_t)(n0 + n) * 1024 + 512 + g * 128 + c8 * 8 + half * 4) = o;
}

struct Args { const float* in[16]; float* out; unsigned char* ws; int ph_lo, ph_hi; };
typedef __attribute__((address_space(4))) const unsigned char* kptr_t;
__device__ __forceinline__ kptr_t kargs_base() { kptr_t p = (kptr_t)__builtin_amdgcn_kernarg_segment_ptr(); asm volatile("" : "+s"(p)); return p; }
__device__ __forceinline__ unsigned long long karg_u64(int off) { return *(const __attribute__((address_space(4))) unsigned long long*)(kargs_base() + off); }
#define GAS1 __attribute__((address_space(1)))
__device__ __forceinline__ const float* karg_in(int i) { return (const float*)(const GAS1 float*)karg_u64(8 * i); }
__device__ __forceinline__ float* karg_out() { return (float*)(GAS1 float*)karg_u64(128); }
__device__ __forceinline__ unsigned char* karg_ws() { return (unsigned char*)(GAS1 unsigned char*)karg_u64(136); }
__device__ __forceinline__ int karg_i32(int off) { return *(const __attribute__((address_space(4))) int*)(kargs_base() + off); }

__device__ __forceinline__ void p0_prologue(unsigned char* ws, LAS unsigned char* lds, int gw, int NGW, int gws, int lane, int wave) {
    LAS float* scr = (LAS float*)(lds + wave * 16384);
    const float* w_in = karg_in(3); const float* pool_w = karg_in(4); const float* pool_scale = karg_in(5); const float* w_out = karg_in(6); const float* ln_ffn = karg_in(7);
    const float* w_up = karg_in(8); const float* w_down = karg_in(11); const float* ln_ple = karg_in(12); const float* w_g = karg_in(13); const float* w_ple = karg_in(14);
    constexpr int I_IN = 16 * 64, I_OT = 8 * 32, I_EFF = 4 * 16 * 32, I_UP = 16 * 176, I_DN = 44 * 32, I_G = 16 * 32, I_PLE = 4 * 32;
    constexpr int NITEMS = I_IN + I_OT + I_EFF + I_UP + I_DN + I_G + I_PLE;
    for (int it = gws; it < NITEMS; it += NGW) {
        int r = it;
        if (r < I_EFF) { const int g = r >> 9, c8 = (r >> 5) & 15, nb = r & 31; weff_item(pool_w, pool_scale, w_out, (bf16*)(ws + WS_WO), g, c8, nb * 32, lane); continue; } r -= I_EFF;
        if (r < I_IN) { const int kb = r >> 6, nb = r & 63; tr_fill(w_in, NZ, kb * 64, nb * 32, karg_in(2), nb < 16 ? 0.125f * 1.4426950408889634f : 1.0f, scr, lane); tr_write((bf16*)(ws + WS_WIN), 1024, nb * 32, kb * 64, scr, lane); continue; } r -= I_IN;
        if (r < I_OT) { const int kb = r >> 5, nb = r & 31; tr_fill(w_out, 1024, kb * 64, nb * 32, nullptr, 1.0f, scr, lane); tr_write((bf16*)(ws + WS_WO), 1024, nb * 32, kb * 64, scr, lane); continue; } r -= I_OT;
        if (r < I_UP) { const int kb = r / 176, nb = r % 176; const int n0 = nb * 32, pn = n0 >> 8, bj = (n0 >> 7) & 1, j = n0 & 127;
            tr_fill(w_up, NUP, kb * 64, bj * FF + pn * 128 + j, ln_ffn, 1.0f, scr, lane); tr_write((bf16*)(ws + WS_WUP), 1024, n0, kb * 64, scr, lane); continue; } r -= I_UP;
        if (r < I_DN) { const int kb = r >> 5, nb = r & 31; tr_fill(w_down, 1024, kb * 64, nb * 32, nullptr, 1.0f, scr, lane); tr_write((bf16*)(ws + WS_WDN), FF, nb * 32, kb * 64, scr, lane); continue; } r -= I_DN;
        if (r < I_G) { const int kb = r >> 5, nb = r & 31; tr_fill(w_g, 1024, kb * 64, nb * 32, ln_ple, 1.0f, scr, lane); tr_write((bf16*)(ws + WS_WG), 1024, nb * 32, kb * 64, scr, lane); continue; } r -= I_G;
        { const int kb = r >> 5, nb = r & 31; tr_fill(w_ple, 1024, kb * 64, nb * 32, nullptr, 1.0f, scr, lane); tr_write((bf16*)(ws + WS_WPLE), PLE, nb * 32, kb * 64, scr, lane); }
    }
    { float* ssz = (float*)(ws + WS_SS1); for (int i = gw * 64 + lane; i < 2 * MT; i += NGW * 64) ssz[i] = 0.f; }
    const float* x = karg_in(0); const float* lnm = karg_in(2); bf16* XN = (bf16*)(ws + WS_XN);
    f32x4 g[4];
#pragma unroll
    for (int j = 0; j < 4; ++j) g[j] = ((const f32x4*)lnm)[lane + 64 * j];
    for (int m = gw; m < MT; m += 2 * NGW) {
        const int m2 = (m + NGW) < MT ? (m + NGW) : (MT - 1);
        const f32x4* xr = (const f32x4*)(x + (size_t)m * DM) + lane; const f32x4* xr2 = (const f32x4*)(x + (size_t)m2 * DM) + lane; f32x4 v[4], u[4]; float s = 0.f, s2 = 0.f;
#pragma unroll
        for (int j = 0; j < 4; ++j) { v[j] = __builtin_nontemporal_load(xr + 64 * j); u[j] = __builtin_nontemporal_load(xr2 + 64 * j); }
#pragma unroll
        for (int j = 0; j < 4; ++j) { s += (v[j].x * v[j].x + v[j].y * v[j].y) + (v[j].z * v[j].z + v[j].w * v[j].w); s2 += (u[j].x * u[j].x + u[j].y * u[j].y) + (u[j].z * u[j].z + u[j].w * u[j].w); }
        const float inv = 1.0f / sqrtf(wave_sum(s) * (1.0f / DM) + 1e-6f), inv2 = 1.0f / sqrtf(wave_sum(s2) * (1.0f / DM) + 1e-6f);
        if (lane == 0) { float* RI = (float*)(ws + WS_RI); RI[m] = inv; RI[m2] = inv2; }
        v2u* o8 = (v2u*)(XN + (size_t)m * DM) + lane; v2u* o82 = (v2u*)(XN + (size_t)m2 * DM) + lane;
#pragma unroll
        for (int j = 0; j < 4; ++j) { v2u w; w.x = pk2(v[j].x, v[j].y); w.y = pk2(v[j].z, v[j].w); o8[64 * j] = w;
            v2u w2; w2.x = pk2(u[j].x, u[j].y); w2.y = pk2(u[j].z, u[j].w); o82[64 * j] = w2; }
    }
    const float* p = karg_in(1); bf16* PB = (bf16*)(ws + WS_PB);
    for (int m = gw; m < MT; m += 4 * NGW) { f32x4 v[4];
#pragma unroll
        for (int j = 0; j < 4; ++j) { const int mj = (m + j * NGW) < MT ? (m + j * NGW) : (MT - 1); v[j] = __builtin_nontemporal_load((const f32x4*)(p + (size_t)mj * PLE) + lane); }
#pragma unroll
        for (int j = 0; j < 4; ++j) { v2u w; w.x = pk2(v[j].x, v[j].y); w.y = pk2(v[j].z, v[j].w); const int mj = (m + j * NGW) < MT ? (m + j * NGW) : (MT - 1); ((v2u*)(PB + (size_t)mj * PLE))[lane] = w; } }
}

__device__ __forceinline__ float other_half(float v) { const auto r = __builtin_amdgcn_permlane32_swap(__float_as_uint(v), __float_as_uint(v), false, false); const unsigned o = (__lane_id() < 32) ? r[1] : r[0]; return __uint_as_float(o); }
__device__ __forceinline__ float max_halves(float v) { const auto r = __builtin_amdgcn_permlane32_swap(__float_as_uint(v), __float_as_uint(v), false, false); return fmaxf(__uint_as_float(r[0]), __uint_as_float(r[1])); }
__device__ __forceinline__ float sum_halves(float v) { const auto r = __builtin_amdgcn_permlane32_swap(__float_as_uint(v), __float_as_uint(v), false, false); return __uint_as_float(r[0]) + __uint_as_float(r[1]); }
__device__ __forceinline__ int crow(int r, int hi) { return (r & 3) + 8 * (r >> 2) + 4 * hi; }
struct AttnIt { int p, h, lsh, r, a0; size_t tokbase; };
__device__ __forceinline__ AttnIt attn_decode(int it) {
    AttnIt A; const int bh = it / 48, rem = it % 48, j = rem & 15; A.p = rem >> 4; A.h = bh & 7; A.lsh = 2 * A.p;
    int chunk; if (A.p == 0) { A.r = 0; chunk = j; } else if (A.p == 1) { A.r = j >> 2; chunk = j & 3; } else { A.r = j; chunk = 0; }
    A.a0 = chunk * 256; A.tokbase = (size_t)(bh >> 3) * SEQ; return A;
}
__device__ __forceinline__ void attn_prefetch(const bf16* Z, const AttnIt& A, int tid, v4u (&kr)[6], v4u (&vr)[6], bf16x8 (&qf)[4]) {
    const unsigned tb = (unsigned)A.tokbase, r = (unsigned)A.r, lsh = (unsigned)A.lsh, hc = (unsigned)A.h * 64u;
#pragma unroll
    for (int i = 0; i < 6; ++i) { const int id = tid + 512 * i, key = id >> 3, pc = id & 7, a = A.a0 - 128 + key; const unsigned ac = a < 0 ? 0u : (unsigned)a;
        kr[i] = *(const v4u*)(Z + ((tb + (ac << lsh) + r) * (unsigned)NZ + 512u + hc + (unsigned)pc * 8u)); }
#pragma unroll
    for (int i = 0; i < 3; ++i) { const int id = tid + 512 * i, pc = id & 7, kp = id >> 3, a = A.a0 - 128 + 2 * kp; const unsigned ac = a < 0 ? 0u : (unsigned)a;
        vr[2 * i] = *(const v4u*)(Z + ((tb + (ac << lsh) + r) * (unsigned)NZ + 1024u + hc + (unsigned)pc * 8u)); vr[2 * i + 1] = *(const v4u*)(Z + ((tb + ((ac + 1u) << lsh) + r) * (unsigned)NZ + 1024u + hc + (unsigned)pc * 8u)); }
    const int w = tid >> 6, lane = tid & 63, q = lane & 31, hi = lane >> 5; const unsigned aq = (unsigned)(A.a0 + 32 * w + q); const unsigned tq = tb + (aq << lsh) + r;
#pragma unroll
    for (int s = 0; s < 4; ++s) qf[s] = *(const bf16x8*)(Z + (tq * (unsigned)NZ + hc + 16u * s + 8u * hi));
}
__device__ __forceinline__ void attn_stage(LAS unsigned char* lds, int tid, const v4u (&kr)[6], const v4u (&vr)[6]) {
    LAS bf16* Ks = (LAS bf16*)lds; LAS unsigned* vt32 = (LAS unsigned*)(lds + 384 * 72 * 2);
#pragma unroll
    for (int i = 0; i < 6; ++i) { const int id = tid + 512 * i, key = id >> 3, pc = id & 7; *(LAS v4u*)(Ks + key * 72 + pc * 8) = kr[i]; }
#pragma unroll
    for (int i = 0; i < 3; ++i) { const int id = tid + 512 * i, pc = id & 7, kp = id >> 3;
        const int k16 = (2 * kp) & 15, kpos = ((2 * kp) & ~15) + ((k16 < 4 || k16 >= 12) ? k16 : (k16 < 8 ? k16 + 4 : k16 - 4));
#pragma unroll
        for (int e2 = 0; e2 < 4; ++e2) { const unsigned w0 = vr[2 * i][e2], w1 = vr[2 * i + 1][e2];
            vt32[((pc * 8 + 2 * e2) * 392 + ((((kpos >> 3) ^ pc) << 3) | (kpos & 7))) >> 1] = (w0 & 0xffffu) | (w1 << 16);
            vt32[((pc * 8 + 2 * e2 + 1) * 392 + ((((kpos >> 3) ^ pc) << 3) | (kpos & 7))) >> 1] = (w0 >> 16) | (w1 & 0xffff0000u); } }
}
__device__ __forceinline__ void attn_compute(LAS unsigned char* lds, bf16* OP, float* ML, const AttnIt& A, int tid, const bf16x8 (&qf)[4]) {
    const int p = A.p, h = A.h, lsh = A.lsh;
    LAS bf16* Ks = (LAS bf16*)lds;
    LAS bf16* Vt = (LAS bf16*)(lds + 384 * 72 * 2);
    const int w = tid >> 6, lane = tid & 63, q = lane & 31, hi = lane >> 5;
    const int aq = A.a0 + 32 * w + q; const size_t tq = A.tokbase + ((size_t)aq << lsh) + A.r;
    const float slope2 = __builtin_amdgcn_exp2f(-(float)(h + 1)) * (float)(1 << lsh) * 1.4426950408889634f;
    const int dmax = aq < 128 ? aq : 128;
    const bool edge = (A.a0 + 32 * w) < 128;
    float mx = -1e30f, l = 0.f;
    f32x16 o[2];
#pragma unroll
    for (int db = 0; db < 2; ++db)
#pragma unroll
        for (int e = 0; e < 16; ++e) o[db][e] = 0.f;
#pragma unroll 1
    for (int kb = 4; kb >= 0; --kb) {
        const int dbase = 128 - 32 * kb + q - 4 * hi; const float c0 = -slope2 * (float)dbase;
        f32x16 st;
#pragma unroll
        for (int e = 0; e < 16; ++e) st[e] = c0 + slope2 * (float)((e & 3) + 8 * (e >> 2));
#pragma unroll
        for (int s = 0; s < 4; ++s) { const bf16x8 kf = *(const LAS bf16x8*)(Ks + (32 * w + 32 * kb + q) * 72 + 16 * s + 8 * hi); st = __builtin_amdgcn_mfma_f32_32x32x16_bf16(kf, qf[s], st, 0, 0, 0); }
        if (kb == 0 || kb == 4 || edge) {
#pragma unroll
            for (int e = 0; e < 16; ++e) { const int diff = dbase - ((e & 3) + 8 * (e >> 2)); st[e] = ((unsigned)diff <= (unsigned)dmax) ? st[e] : -1e30f; }
        }
        float bm = fmaxf(fmaxf(st[0], st[1]), st[2]);
#pragma unroll
        for (int e = 3; e < 15; e += 2) bm = fmaxf(fmaxf(bm, st[e]), st[e + 1]);
        bm = fmaxf(bm, st[15]);
        bm = max_halves(bm);
        const float mn = fmaxf(mx, bm);
        if (__builtin_amdgcn_ballot_w64(mn > mx)) { const float sc = __builtin_amdgcn_exp2f(mx - mn); l *= sc;
#pragma unroll
            for (int db = 0; db < 2; ++db)
#pragma unroll
                for (int e = 0; e < 16; ++e) o[db][e] *= sc; }
        mx = mn;
        float ls = 0.f;
#pragma unroll
        for (int e = 0; e < 16; ++e) { const float pv = __builtin_amdgcn_exp2f(st[e] - mn); st[e] = pv; ls += pv; }
        l += ls;
#pragma unroll
        for (int s2 = 0; s2 < 2; ++s2) {
            v4u pw; pw.x = pk2(st[8 * s2 + 0], st[8 * s2 + 1]); pw.y = pk2(st[8 * s2 + 2], st[8 * s2 + 3]); pw.z = pk2(st[8 * s2 + 4], st[8 * s2 + 5]); pw.w = pk2(st[8 * s2 + 6], st[8 * s2 + 7]);
            const bf16x8 pf = __builtin_bit_cast(bf16x8, pw);
#pragma unroll
            for (int db = 0; db < 2; ++db) { const bf16x8 vf = *(const LAS bf16x8*)(Vt + (32 * db + q) * 392 + (((4 * w + 4 * kb + 2 * s2 + hi) ^ ((4 * db + (q >> 3)) & 7)) << 3));
                o[db] = __builtin_amdgcn_mfma_f32_32x32x16_bf16(vf, pf, o[db], 0, 0, 0); } }
    }
    l = sum_halves(l);
    const float il = 1.0f / l;
    bf16* op = OP + ((size_t)p * MT + tq) * 512 + h * 64 + 8 * hi;
#pragma unroll
    for (int db = 0; db < 2; ++db)
#pragma unroll
        for (int g4 = 0; g4 < 4; g4 += 2) {
            v2u a, b; a.x = pk2(o[db][4 * g4] * il, o[db][4 * g4 + 1] * il); a.y = pk2(o[db][4 * g4 + 2] * il, o[db][4 * g4 + 3] * il);
            b.x = pk2(o[db][4 * g4 + 4] * il, o[db][4 * g4 + 5] * il); b.y = pk2(o[db][4 * g4 + 6] * il, o[db][4 * g4 + 7] * il);
            { auto r = __builtin_amdgcn_permlane32_swap(a.x, b.x, false, false); a.x = r[0]; b.x = r[1]; }
            { auto r = __builtin_amdgcn_permlane32_swap(a.y, b.y, false, false); a.y = r[0]; b.y = r[1]; }
            v4u w; w.x = a.x; w.y = a.y; w.z = b.x; w.w = b.y;
            *(v4u*)(op + 32 * db + 8 * g4) = w; }
    if (hi == 0) { float* mp = ML + (((size_t)p * MT + tq) * 8 + h) * 2; mp[0] = mx; mp[1] = l; }
}

template <int MODE  > __device__ __forceinline__ void merge_pool(const bf16* Z, const bf16* OP, const float* ML, bf16* MIX, int gtid, int nthr) {
    if (MODE == 1) {
#pragma unroll 2
    for (int idx0 = gtid; idx0 < MT * 64; idx0 += 2 * nthr) {
        int id[2]; id[0] = idx0; id[1] = (idx0 + nthr) < MT * 64 ? (idx0 + nthr) : idx0;
        float mm_[2][3], ll_[2][3]; v4u ov[2][3];
#pragma unroll
        for (int k = 0; k < 2; ++k) { const int tok = id[k] >> 6, hh = (id[k] >> 3) & 7, pc = id[k] & 7;
#pragma unroll
            for (int p = 0; p < 3; ++p) { const float* mp = ML + (((size_t)p * MT + tok) * 8 + hh) * 2; const v2u t = *(const v2u*)mp; mm_[k][p] = __uint_as_float(t.x); ll_[k][p] = __uint_as_float(t.y);
                ov[k][p] = __builtin_nontemporal_load((const v4u*)(OP + ((size_t)p * MT + tok) * 512 + hh * 64 + pc * 8)); } }
#pragma unroll
        for (int k = 0; k < 2; ++k) { const int tok = id[k] >> 6, hh = (id[k] >> 3) & 7, pc = id[k] & 7;
            const float mm = fmaxf(mm_[k][0], fmaxf(mm_[k][1], mm_[k][2])); float wgt[3], wsum = 0.f;
#pragma unroll
            for (int p = 0; p < 3; ++p) { wgt[p] = ll_[k][p] * __builtin_amdgcn_exp2f(mm_[k][p] - mm); wsum += wgt[p]; }
            const float iw = 1.0f / wsum; float acc[8];
#pragma unroll
            for (int e = 0; e < 8; ++e) acc[e] = 0.f;
#pragma unroll
            for (int p = 0; p < 3; ++p) { const float wp = wgt[p] * iw;
#pragma unroll
                for (int e2 = 0; e2 < 4; ++e2) { acc[2 * e2] += wp * blo(ov[k][p][e2]); acc[2 * e2 + 1] += wp * bhi(ov[k][p][e2]); } }
            v4u o; o.x = pk2(acc[0], acc[1]); o.y = pk2(acc[2], acc[3]); o.z = pk2(acc[4], acc[5]); o.w = pk2(acc[6], acc[7]);
            *(v4u*)(MIX + (size_t)tok * 1024 + hh * 64 + pc * 8) = o; }
    }
    }
    if (MODE == 2) {
#pragma unroll 2
    for (int idx = gtid; idx < (MT / 8) * 64; idx += nthr) {
        const int tg = idx >> 6, cb = idx & 63, g = cb >> 4, wdw = 2 << g, tok0 = tg * 8, t0 = tok0 & (SEQ - 1);
        const bf16* up = Z + (size_t)tok0 * NZ + 1536 + cb * 8;
        float sum[8];
#pragma unroll
        for (int e = 0; e < 8; ++e) sum[e] = 0.f;
        const int back = (wdw - 1) < t0 ? (wdw - 1) : t0;
        for (int i = 1; i <= back; ++i) { const v4u v = *(const v4u*)(up - (size_t)i * NZ);
#pragma unroll
            for (int e2 = 0; e2 < 4; ++e2) { sum[2 * e2] += blo(v[e2]); sum[2 * e2 + 1] += bhi(v[e2]); } }
        v4u cur[8];
#pragma unroll
        for (int jj = 0; jj < 8; ++jj) cur[jj] = *(const v4u*)(up + (size_t)jj * NZ);
#pragma unroll
        for (int jj = 0; jj < 8; ++jj) {
#pragma unroll
            for (int e2 = 0; e2 < 4; ++e2) { sum[2 * e2] += blo(cur[jj][e2]); sum[2 * e2 + 1] += bhi(cur[jj][e2]); }
            const int t = t0 + jj; const int cnt = (t + 1) < wdw ? (t + 1) : wdw; const float ic = 1.0f / (float)cnt;
            v4u o; o.x = pk2(sum[0] * ic - blo(cur[jj].x), sum[1] * ic - bhi(cur[jj].x)); o.y = pk2(sum[2] * ic - blo(cur[jj].y), sum[3] * ic - bhi(cur[jj].y));
            o.z = pk2(sum[4] * ic - blo(cur[jj].z), sum[5] * ic - bhi(cur[jj].z)); o.w = pk2(sum[6] * ic - blo(cur[jj].w), sum[7] * ic - bhi(cur[jj].w));
            *(v4u*)(MIX + (size_t)(tok0 + jj) * 1024 + 512 + cb * 8) = o;
            const int tout = t + 1 - wdw;
            if (jj < 7 && tout >= 0) { const v4u v = *(const v4u*)(up + ((ptrdiff_t)(jj + 1) - wdw) * NZ);
#pragma unroll
                for (int e2 = 0; e2 < 4; ++e2) { sum[2 * e2] -= blo(v[e2]); sum[2 * e2 + 1] -= bhi(v[e2]); } }
        }
    }
    }
}

__device__ __forceinline__ void conv_fixup_panel(const float* halo, const float* cw, const float* cb, bf16* act, int pm, int tid) {
    if ((pm & 15) == 0) return;
    for (int idx = tid; idx < 2 * (FF / 4); idx += NWAVES * 64) {
        const int rs = idx / (FF / 4), gc = (idx % (FF / 4)) * 4, pn = gc >> 7, j = gc & 127;
        f32x4 y[2];
#pragma unroll
        for (int bj = 0; bj < 2; ++bj) { const int c = bj * FF + gc;
#define HAL(pm_, rsel_) (*(const f32x4*)(halo + ((size_t)((pm_) * 4 + (rsel_)) * 22 + pn) * 256 + bj * 128 + j))
            f32x4 u0, um1, um2;
            if (rs == 0) { u0 = HAL(pm, 0); um1 = HAL(pm - 1, 3); um2 = HAL(pm - 1, 2); } else { u0 = HAL(pm, 1); um1 = HAL(pm, 0); um2 = HAL(pm - 1, 3); }
#undef HAL
            y[bj] = *(const f32x4*)(cw + c) * um2 + *(const f32x4*)(cw + NUP + c) * um1 + *(const f32x4*)(cw + 2 * NUP + c) * u0 + *(const f32x4*)(cb + c); }
        f32x4 a;
#pragma unroll
        for (int e2 = 0; e2 < 4; ++e2) a[e2] = y[0][e2] * pg8::sigmoidf_(y[0][e2]) * y[1][e2];
        v2u w; w.x = pk2(a[0], a[1]); w.y = pk2(a[2], a[3]);
        *(v2u*)(act + (size_t)(pm * 256 + rs) * FF + gc) = w;
    }
}

#define XB_TMO      128
#define XB_XCNT(j)  (256  + 64 * (j))
#define XB_XSUB(j)  (1280 + 64 * (j))
#define XB_XGEN(j)  (2304 + 64 * (j))
#define XB_TOP      3328
#define XB_TOPGEN   3392
#define XCD_BAR_WORDS 3456
#define XB_SPIN_CAP (1u << 18)

__device__ __forceinline__ unsigned xb_ld(unsigned* p)              { return __hip_atomic_load(p, __ATOMIC_RELAXED, __HIP_MEMORY_SCOPE_AGENT); }
__device__ __forceinline__ unsigned xb_add(unsigned* p, unsigned v) { return __hip_atomic_fetch_add(p, v, __ATOMIC_RELAXED, __HIP_MEMORY_SCOPE_AGENT); }
__device__ __forceinline__ unsigned xb_xcc_id() { return (unsigned)__builtin_amdgcn_s_getreg((3 << 11) | 20) & 0xFu; }
#define XB_SPIN(cond, bar) do { unsigned _sp = 0; while (cond) { __builtin_amdgcn_s_sleep(1); \
    if ((++_sp & 255u) == 0u) { if (xb_ld(&(bar)[XB_TMO])) break; if (_sp > XB_SPIN_CAP) { atomicAdd(&(bar)[XB_TMO], 1u); break; } } } } while (0)

struct XcdBarrier {
    unsigned* bar; unsigned x;
    volatile LAS unsigned* st;
};

__device__ __forceinline__ XcdBarrier xcd_barrier_post(unsigned* bar, volatile LAS unsigned* st) {
    XcdBarrier b; b.bar = bar; b.x = xb_xcc_id(); b.st = st;
    if (threadIdx.x == 0) (void)xb_add(&bar[XB_XCNT(b.x)], 1u);
    return b;
}
__device__ __forceinline__ void xcd_barrier_complete(unsigned* bar, unsigned x, unsigned& nloc, unsigned& nx) {
    const unsigned G = gridDim.x * gridDim.y * gridDim.z;
    unsigned sum, cnt, mine, sp = 0u;
    for (;;) {
        sum = 0u; cnt = 0u; mine = 0u;
#pragma unroll
        for (unsigned j = 0; j < 16; ++j) { const unsigned c = xb_ld(&bar[XB_XCNT(j)]); sum += c; cnt += (c > 0u) ? 1u : 0u; mine = (j == x) ? c : mine; }
        if (sum == G) break;
        __builtin_amdgcn_s_sleep(1);
        if ((++sp & 255u) == 0u) { if (xb_ld(&bar[XB_TMO])) break; if (sp > XB_SPIN_CAP) { atomicAdd(&bar[XB_TMO], 1u); break; } }
    }
    nloc = mine > 0u ? mine : 1u; nx = cnt > 0u ? cnt : 1u;
}

__device__ __forceinline__ void xcd_barrier(const XcdBarrier& b) {
    asm volatile("s_waitcnt vmcnt(0)" ::: "memory");
    __syncthreads();
    if (threadIdx.x == 0) {
        unsigned* bar = b.bar;
        __builtin_amdgcn_s_waitcnt(0);
        unsigned nloc = b.st[0], nx = b.st[1];
        if (nloc == 0u) { xcd_barrier_complete(bar, b.x, nloc, nx); b.st[0] = nloc; b.st[1] = nx; }
        const unsigned old = xb_add(&bar[XB_XSUB(b.x)], 1u);
        const unsigned gen = old / nloc;
        if (old + 1u == (gen + 1u) * nloc) {
            __builtin_amdgcn_fence(__ATOMIC_RELEASE, "agent");
            asm volatile("s_waitcnt vmcnt(0)" ::: "memory");
            const unsigned og = xb_add(&bar[XB_TOP], 1u);
            const unsigned tg = og / nx;
            if (og + 1u == (tg + 1u) * nx) xb_add(&bar[XB_TOPGEN], 1u);
            else XB_SPIN(xb_ld(&bar[XB_TOPGEN]) == tg, bar);
            __builtin_amdgcn_fence(__ATOMIC_ACQUIRE, "agent");
            xb_add(&bar[XB_XGEN(b.x)], 1u);
            asm volatile("s_waitcnt vmcnt(0)" ::: "memory");
        } else {
            XB_SPIN(xb_ld(&bar[XB_XGEN(b.x)]) == gen, bar);
            __builtin_amdgcn_fence(__ATOMIC_ACQUIRE, "agent");
            asm volatile("s_waitcnt vmcnt(0)" ::: "memory");
        }
    }
    __syncthreads();
}


__device__ __forceinline__ void atomic_grid_barrier(unsigned* ctr, unsigned nblocks) {
    asm volatile("s_waitcnt vmcnt(0)" ::: "memory");
    __syncthreads();
    if (threadIdx.x == 0) {
        __builtin_amdgcn_fence(__ATOMIC_RELEASE, "agent");
        asm volatile("s_waitcnt vmcnt(0)" ::: "memory");
        __hip_atomic_fetch_add(ctr, 1u, __ATOMIC_RELAXED, __HIP_MEMORY_SCOPE_AGENT);
        while (__hip_atomic_load(ctr, __ATOMIC_RELAXED, __HIP_MEMORY_SCOPE_AGENT) < nblocks) __builtin_amdgcn_s_sleep(2);
        __builtin_amdgcn_fence(__ATOMIC_ACQUIRE, "agent");
        asm volatile("s_waitcnt vmcnt(0)" ::: "memory");
    }
    __syncthreads();
}


constexpr int NPH = 10;
#ifndef REPS
#define REPS {1,1,1,1,1,1,1,1,1,1}
#endif
__device__ constexpr int kReps[10] = REPS;
__global__ void __launch_bounds__(NWAVES * 64, 2) hybrid_fwd(Args args) {
    extern __shared__ __attribute__((aligned(16))) unsigned char lds_raw[];
    LAS unsigned char* lds = (LAS unsigned char*)lds_raw;
    cg::grid_group grid = cg::this_grid();
    if (threadIdx.x < 2) ((LAS unsigned*)(lds + 131072 + 8192))[threadIdx.x] = 0u;
    __syncthreads();
    const int tid = threadIdx.x, lane = tid & 63, wave = __builtin_amdgcn_readfirstlane(tid >> 6);
    const int G = gridDim.x, bx = blockIdx.x;
    const int gw = bx * NWAVES + wave, NGW = G * NWAVES, gws = wave * G + bx;
    const int gtid = bx * (NWAVES * 64) + tid, nthr = G * NWAVES * 64;
    unsigned char* ws = karg_ws();
    bf16* XN = (bf16*)(ws + WS_XN); bf16* PB = (bf16*)(ws + WS_PB); bf16* EB = (bf16*)(ws + WS_E); bf16* Z = (bf16*)(ws + WS_Z);
    bf16* OP = (bf16*)(ws + WS_OP); float* ML = (float*)(ws + WS_ML); bf16* MIX = (bf16*)(ws + WS_MIX); float* HALO = (float*)(ws + WS_HALO);
    float* SS1 = (float*)(ws + WS_SS1); float* SS2 = (float*)(ws + WS_SS2); bf16* ACT = (bf16*)(ws + WS_ACT);
    const int lo = karg_i32(144), hi = karg_i32(148);
    XcdBarrier xbar = xcd_barrier_post((unsigned*)ws + 1024, (volatile LAS unsigned*)(lds + 131072 + 8192));
    if (lo > hi) grid.sync();
#ifndef PHMASK
#define PHMASK 0x3ff
#endif
#define IN(k) (((PHMASK >> (k)) & 1) && lo <= (k) && (k) < hi)
#define SEAM(k) do { if (IN(k) && IN((k) + 1)) xcd_barrier(xbar); } while (0)

    if (IN(0)) for (int rep_ = 0; rep_ < kReps[0]; ++rep_) { p0_prologue(ws, lds, gw, NGW, gws, lane, wave); }
    SEAM(0);
    if (IN(1)) for (int rep_ = 0; rep_ < kReps[1]; ++rep_) {
        { pg8::Gemm g{XN, (const bf16*)(ws + WS_WIN), MT, NZ, DM}; pg8::StaticOrder S; S.init(MT, NZ, G, bx); pg8::EpiStoreBf16T<true> E{Z, NZ, (const float*)(ws + WS_RI)};
          pg8::gemm_phase<pg8::EpiStoreBf16T<true>, pg8::StaticOrder, true, true>(lds, g, S, E); }
    }
    SEAM(1);
    if (IN(2)) for (int rep_ = 0; rep_ < kReps[2]; ++rep_) {
        v4u kr[6], vr[6]; bf16x8 qn[4]; int it = bx;
        AttnIt An = attn_decode(it); attn_prefetch(Z, An, tid, kr, vr, qn);
        merge_pool<2>(Z, OP, ML, MIX, gtid, nthr);
#pragma unroll 1
        for (; it < 64 * 48; it += G) {
            const AttnIt Ac = An; bf16x8 qc[4];
#pragma unroll
            for (int s = 0; s < 4; ++s) qc[s] = qn[s];
            attn_stage(lds, tid, kr, vr);
            __syncthreads();
            if (it + G < 64 * 48) { An = attn_decode(it + G); attn_prefetch(Z, An, tid, kr, vr, qn); }
            attn_compute(lds, OP, ML, Ac, tid, qc);
            __syncthreads();
        }
    }
    SEAM(2);
    if (IN(3)) for (int rep_ = 0; rep_ < kReps[3]; ++rep_) { merge_pool<1>(Z, OP, ML, MIX, gtid, nthr); }
    SEAM(3);
    if (IN(4)) for (int rep_ = 0; rep_ < kReps[4]; ++rep_) {
        pg8::Gemm g{MIX, (const bf16*)(ws + WS_WO), MT, DM, DM}; pg8::StaticOrder S; S.init(MT, DM, G, bx); pg8::EpiRes<false> E{nullptr, XN, SS1};
        pg8::gemm_phase<pg8::EpiRes<false>, pg8::StaticOrder, true, true>(lds, g, S, E);
    }
    SEAM(4);
    if (IN(5)) for (int rep_ = 0; rep_ < kReps[5]; ++rep_) {
        pg8::Gemm g{XN, (const bf16*)(ws + WS_WUP), MT, NUP, DM}; pg8::StaticOrder S; S.init(MT, NUP, G, bx); pg8::EpiConv E{SS1, karg_in(9), karg_in(10), ACT, HALO};
        pg8::gemm_phase<pg8::EpiConv, pg8::StaticOrder, true, true>(lds, g, S, E);
    }
    SEAM(5);
    if (IN(7)) {
        { const int t7 = (int)__builtin_amdgcn_mbcnt_hi(~0u, __builtin_amdgcn_mbcnt_lo(~0u, 0u)) + 64 * __builtin_amdgcn_readfirstlane((int)threadIdx.x >> 6);
          pg8::StaticOrder S0; S0.init(MT, DM, G, bx); pg8::Unit u0; const float* cwp = karg_in(9); const float* cbp = karg_in(10);
          for (int i = 0; S0.next(i, u0); ++i) conv_fixup_panel(HALO, cwp, cbp, ACT, u0.pm, t7);
          asm volatile("s_waitcnt vmcnt(0)" ::: "memory"); __syncthreads();
          if (threadIdx.x == 0) { __builtin_amdgcn_fence(__ATOMIC_ACQUIRE, "agent"); asm volatile("s_waitcnt vmcnt(0)" ::: "memory"); }
          __syncthreads(); }
#ifdef PROBE_P7
        { pg8::Gemm g{ACT, (const bf16*)(ws + WS_WDN), MT, DM, FF}; pg8::StaticOrder S; S.init(MT, DM, G, bx); pg8::EpiStoreBf16 E{MIX, DM, nullptr}; pg8::gemm_phase<pg8::EpiStoreBf16, pg8::StaticOrder, true, true>(lds, g, S, E); }
#endif
        pg8::Gemm g{ACT, (const bf16*)(ws + WS_WDN), MT, DM, FF}; pg8::StaticOrder S; S.init(MT, DM, G, bx); pg8::EpiRes<false> E{nullptr, XN, SS2};
        pg8::gemm_phase<pg8::EpiRes<false>, pg8::StaticOrder, true, true>(lds, g, S, E);
        { pg8::Gemm g{PB, (const bf16*)(ws + WS_WPLE), MT, DM, PLE}; pg8::StaticOrder S; S.init(MT, DM, G, bx); pg8::EpiStoreBf16 E{EB, DM, nullptr};
          pg8::gemm_phase<pg8::EpiStoreBf16, pg8::StaticOrder, true, true>(lds, g, S, E); }
    }
    SEAM(7);
    if (IN(8)) for (int rep_ = 0; rep_ < kReps[8]; ++rep_) {
        pg8::Gemm g{XN, (const bf16*)(ws + WS_WG), MT, DM, DM}; pg8::StaticOrder S; S.init(MT, DM, G, bx); pg8::EpiGate E{SS2, EB, XN, MIX};
        pg8::gemm_phase<pg8::EpiGate, pg8::StaticOrder, true, true>(lds, g, S, E);
    }
    SEAM(8);
    if (IN(9)) for (int rep_ = 0; rep_ < kReps[9]; ++rep_) {
        const int lane9 = (int)__builtin_amdgcn_mbcnt_hi(~0u, __builtin_amdgcn_mbcnt_lo(~0u, 0u)); const int gw9 = bx * NWAVES + __builtin_amdgcn_readfirstlane((int)threadIdx.x >> 6);
        const float* lnf = karg_in(15); float* outp = karg_out(); f32x4 g[4];
#pragma unroll
        for (int j = 0; j < 4; ++j) g[j] = ((const f32x4*)lnf)[lane9 + 64 * j];
        for (int m = gw9; m < MT; m += 2 * NGW) {
            const int m2 = (m + NGW) < MT ? (m + NGW) : (MT - 1);
            const v2u* hr = (const v2u*)(MIX + (size_t)m * DM) + lane9; const v2u* hr2 = (const v2u*)(MIX + (size_t)m2 * DM) + lane9; v2u a[4], b[4];
#pragma unroll
            for (int j = 0; j < 4; ++j) { a[j] = __builtin_nontemporal_load(hr + 64 * j); b[j] = __builtin_nontemporal_load(hr2 + 64 * j); }
            f32x4 v[4], u[4]; float s = 0.f, s2 = 0.f;
#pragma unroll
            for (int j = 0; j < 4; ++j) { v[j] = (f32x4){blo(a[j].x), bhi(a[j].x), blo(a[j].y), bhi(a[j].y)}; u[j] = (f32x4){blo(b[j].x), bhi(b[j].x), blo(b[j].y), bhi(b[j].y)};
                s += (v[j].x * v[j].x + v[j].y * v[j].y) + (v[j].z * v[j].z + v[j].w * v[j].w); s2 += (u[j].x * u[j].x + u[j].y * u[j].y) + (u[j].z * u[j].z + u[j].w * u[j].w); }
            const float inv = 1.0f / sqrtf(wave_sum(s) * (1.0f / DM) + 1e-6f), inv2 = 1.0f / sqrtf(wave_sum(s2) * (1.0f / DM) + 1e-6f);
            f32x4* xr = (f32x4*)(outp + (size_t)m * DM) + lane9; f32x4* xr2 = (f32x4*)(outp + (size_t)m2 * DM) + lane9;
#pragma unroll
            for (int j = 0; j < 4; ++j) { __builtin_nontemporal_store(v[j] * inv * g[j], xr + 64 * j); __builtin_nontemporal_store(u[j] * inv2 * g[j], xr2 + 64 * j); }
        }
    }
#undef IN
#undef SEAM
}

#ifndef N_LAUNCHES
#define N_LAUNCHES 1
#endif
extern "C" void kernel_launch(void* const* d_in, const int* in_sizes, int n_in, void* d_out, int out_size, void* d_ws, size_t ws_size, hipStream_t stream) {
    static int grid = 0;
    if (grid == 0) {
        if (n_in != 16 || out_size != MT * DM || ws_size < WS_END) { fprintf(stderr, "kernel_launch: unexpected shapes (n_in %d out %d ws %zu)\n", n_in, out_size, ws_size); grid = -1; return; }
        int dev = 0, cus = 0, per_cu = 0;
        hipGetDevice(&dev); hipDeviceGetAttribute(&cus, hipDeviceAttributeMultiprocessorCount, dev);
        if (hipFuncSetAttribute((const void*)hybrid_fwd, hipFuncAttributeMaxDynamicSharedMemorySize, LDS_BYTES) != hipSuccess) { fprintf(stderr, "kernel_launch: hipFuncSetAttribute failed\n"); grid = -1; return; }
        if (hipOccupancyMaxActiveBlocksPerMultiprocessor(&per_cu, (const void*)hybrid_fwd, NWAVES * 64, LDS_BYTES) != hipSuccess || per_cu < 1) { fprintf(stderr, "kernel_launch: occupancy query says %d\n", per_cu); per_cu = 1; }
        (void)hipGetLastError();
        grid = cus * (per_cu > 1 ? 1 : per_cu);
    }
    if (grid < 0) return;
    if (hipMemsetAsync(d_ws, 0, 32768, stream) != hipSuccess) { fprintf(stderr, "kernel_launch: memset failed\n"); return; }
    Args a{};
    for (int i = 0; i < 16; ++i) a.in[i] = (const float*)d_in[i];
    a.out = (float*)d_out; a.ws = (unsigned char*)d_ws;
    if (N_LAUNCHES == 1) {
        a.ph_lo = 0; a.ph_hi = NPH;
        void* kargs[] = {&a};
        hipError_t e = hipLaunchCooperativeKernel((const void*)hybrid_fwd, dim3(grid), dim3(NWAVES * 64), kargs, LDS_BYTES, stream);
        if (e != hipSuccess) fprintf(stderr, "cooperative launch failed: %s (grid %d)\n", hipGetErrorString(e), grid);
    } else {
        for (int k = 0; k < NPH; ++k) { a.ph_lo = k; a.ph_hi = k + 1; hipLaunchKernelGGL(hybrid_fwd, dim3(grid), dim3(NWAVES * 64), LDS_BYTES, stream, a); }
    }
}
```

```cpp
#include <hip/hip_runtime.h>
#include <hip/hip_cooperative_groups.h>
#include <cstdio>
#include <cstdint>
namespace cg = cooperative_groups;
namespace pg8 {
#define PG8_LAS __attribute__((address_space(3)))
typedef unsigned short bf16_t;
typedef short bf16x8 __attribute__((ext_vector_type(8)));
typedef float f32x4 __attribute__((ext_vector_type(4)));
typedef unsigned u32x4 __attribute__((ext_vector_type(4)));
constexpr int BM = 256, BK = 64, HALF = 128, HTB = HALF * BK * 2  , STAGE_BYTES = 8 * HTB, NXCD = 8, WGM = 8;

__host__ __device__ __forceinline__ int lds_byte(int r, int c) { const int st = (r >> 4) * 2 + (c >> 5), rr = r & 15, cc = c & 31, ob = rr * 64 + cc * 2; return st * 1024 + (ob ^ (((ob >> 9) & 1) << 5)); }
__host__ __device__ __forceinline__ void stage_rc(int b, int& R, int& C) { const int st = b / 1024, sb = b % 1024, swz = sb ^ (((sb >> 9) & 1) << 5); R = (st >> 1) * 16 + swz / 64; C = (st & 1) * 32 + (swz % 64) / 2; }
__host__ __device__ __forceinline__ int perm32(int rho) { const int n = rho >> 4, i = rho & 15; return 8 * (i >> 2) + 4 * n + (i & 3); }

struct Unit { int pm, pn; };
struct Gemm { const bf16_t* A; const bf16_t* Bt; int M, N, K; };

struct StaticOrder {
    int nM, nN, nwg, G, c;
    __host__ __device__ void init(int M, int N, int G_, int c_) { nM = M / BM; nN = N / BM; nwg = nM * nN; G = G_; c = c_; }
    __host__ __device__ bool next(int i, Unit& u) const {
        const long L = (long)i * G + c; if (L >= nwg) return false;
        int wgid = (int)L; { const int q = nwg / NXCD, r = nwg % NXCD, xcd = wgid % NXCD, off = wgid / NXCD; wgid = (xcd < r ? xcd * (q + 1) : r * (q + 1) + (xcd - r) * q) + off; }
        const int nig = WGM * nN, gid = wgid / nig, fm = gid * WGM, gsz = (nM - fm) < WGM ? (nM - fm) : WGM;
        u.pm = fm + ((wgid % nig) % gsz); u.pn = (wgid % nig) / gsz; return true;
    }
    __device__ __forceinline__ void a_ready(const Unit&) const {}
    __device__ __forceinline__ void done(const Unit&) const {}
};

__device__ __forceinline__ unsigned cvt_pk_bf16(float lo, float hi) { unsigned r; asm volatile("v_cvt_pk_bf16_f32 %0, %1, %2" : "=v"(r) : "v"(lo), "v"(hi)); return r; }
typedef unsigned u32x2 __attribute__((ext_vector_type(2)));
typedef float f32x2 __attribute__((ext_vector_type(2)));
__device__ __forceinline__ float bf_lo(unsigned w) { return __uint_as_float(w << 16); }
__device__ __forceinline__ float bf_hi(unsigned w) { return __uint_as_float(w & 0xffff0000u); }

template <bool ROWSCALE> struct EpiStoreBf16T {
    static constexpr bool PERM = true, AFTER_DRAIN = false, LINE = true;
    bf16_t* O; int ldc; const float* rs;
    __device__ __forceinline__ void operator()(f32x4 (&acc)[2][2][4][2], const Unit& u, int wr, int wc, int fr, int fq, PG8_LAS unsigned char*) const {
        const int row0 = u.pm * BM + wr * 64 + fr, col0 = u.pn * BM + wc * 64 + 8 * fq;
        float sc[2][4];
        if (ROWSCALE) {
#pragma unroll
            for (int ai = 0; ai < 2; ++ai)
#pragma unroll
                for (int m = 0; m < 4; ++m) sc[ai][m] = rs[row0 + ai * HALF + m * 16];
        }
#pragma unroll
        for (int ai = 0; ai < 2; ++ai)
#pragma unroll
            for (int m = 0; m < 4; ++m) { bf16_t* rowp = O + (size_t)(row0 + ai * HALF + m * 16) * ldc + col0;
#pragma unroll
                for (int bj = 0; bj < 2; ++bj) { f32x4 v0 = acc[ai][bj][m][0], v1 = acc[ai][bj][m][1];
                    if (ROWSCALE) { v0 = v0 * sc[ai][m]; v1 = v1 * sc[ai][m]; }
                    u32x4 w; w.x = cvt_pk_bf16(v0[0], v0[1]); w.y = cvt_pk_bf16(v0[2], v0[3]); w.z = cvt_pk_bf16(v1[0], v1[1]); w.w = cvt_pk_bf16(v1[2], v1[3]);
                    *(u32x4*)(rowp + bj * 32) = w; } }
    }
};
typedef EpiStoreBf16T<false> EpiStoreBf16;

template <bool BASE_F32> struct EpiRes {
    static constexpr bool PERM = true, AFTER_DRAIN = false, LINE = true;
    const float* base; bf16_t* hb; float* ss;
    __device__ __forceinline__ void operator()(f32x4 (&acc)[2][2][4][2], const Unit& u, int wr, int wc, int fr, int fq, PG8_LAS unsigned char*) const {
        const int col0 = u.pn * BM + wc * 64 + 8 * fq;
#pragma unroll
        for (int ai = 0; ai < 2; ++ai) {
            int r0 = u.pm * BM + ai * HALF + wr * 64 + fr; asm volatile("" : "+v"(r0));
            const size_t off0 = (size_t)r0 * 1024 + col0;
            f32x4 bq[4][2][2]; u32x4 bh[4][2];
#pragma unroll
            for (int m = 0; m < 4; ++m)
#pragma unroll
                for (int bj = 0; bj < 2; ++bj) { const size_t o = off0 + (size_t)m * 16 * 1024 + bj * 32;
                    if (BASE_F32) { bq[m][bj][0] = *(const f32x4*)(base + o); bq[m][bj][1] = *(const f32x4*)(base + o + 4); } else bh[m][bj] = *(const u32x4*)(hb + o); }
#pragma unroll
            for (int m = 0; m < 4; ++m) { float s = 0.f;
#pragma unroll
                for (int bj = 0; bj < 2; ++bj) { const size_t o = off0 + (size_t)m * 16 * 1024 + bj * 32; f32x4 b0, b1;
                    if (BASE_F32) { b0 = bq[m][bj][0]; b1 = bq[m][bj][1]; }
                    else { const u32x4 bw = bh[m][bj]; b0 = (f32x4){bf_lo(bw.x), bf_hi(bw.x), bf_lo(bw.y), bf_hi(bw.y)}; b1 = (f32x4){bf_lo(bw.z), bf_hi(bw.z), bf_lo(bw.w), bf_hi(bw.w)}; }
                    const f32x4 o0 = b0 + acc[ai][bj][m][0], o1 = b1 + acc[ai][bj][m][1];
                    u32x4 w; w.x = cvt_pk_bf16(o0[0], o0[1]); w.y = cvt_pk_bf16(o0[2], o0[3]); w.z = cvt_pk_bf16(o1[0], o1[1]); w.w = cvt_pk_bf16(o1[2], o1[3]);
                    *(u32x4*)(hb + o) = w;
                    s += ((o0[0] * o0[0] + o0[1] * o0[1]) + (o0[2] * o0[2] + o0[3] * o0[3])) + ((o1[0] * o1[0] + o1[1] * o1[1]) + (o1[2] * o1[2] + o1[3] * o1[3])); }
                s += __shfl_xor(s, 16); s += __shfl_xor(s, 32);
                if (fq == 0) (void)__hip_atomic_fetch_add(ss + r0 + m * 16, s, __ATOMIC_RELAXED, __HIP_MEMORY_SCOPE_AGENT); }
            asm volatile("" ::: "memory"); __builtin_amdgcn_sched_barrier(0);
        }
    }
};

__device__ __forceinline__ float inv_from_ss(float t) { return __builtin_amdgcn_rsqf(t * (1.0f / 1024.0f) + 1e-6f); }
__device__ __forceinline__ float sigmoidf_(float x) { return __builtin_amdgcn_rcpf(1.0f + __builtin_amdgcn_exp2f(-1.4426950408889634f * x)); }

struct EpiGate {
    static constexpr bool PERM = true, AFTER_DRAIN = false, LINE = true;
    const float* ss_in; const bf16_t* E; const bf16_t* hb; bf16_t* out;
    __device__ __forceinline__ void operator()(f32x4 (&acc)[2][2][4][2], const Unit& u, int wr, int wc, int fr, int fq, PG8_LAS unsigned char*) const {
        const int col0 = u.pn * BM + wc * 64 + 8 * fq;
#pragma unroll
        for (int ai = 0; ai < 2; ++ai) {
            int r0 = u.pm * BM + ai * HALF + wr * 64 + fr; asm volatile("" : "+v"(r0));
            const size_t off0 = (size_t)r0 * 1024 + col0;
            u32x4 hv[4][2], ev[4][2]; float sq[4];
#pragma unroll
            for (int m = 0; m < 4; ++m) { sq[m] = ss_in[r0 + m * 16];
#pragma unroll
                for (int bj = 0; bj < 2; ++bj) { const size_t o = off0 + (size_t)m * 16 * 1024 + bj * 32; hv[m][bj] = *(const u32x4*)(hb + o); ev[m][bj] = *(const u32x4*)(E + o); } }
#pragma unroll
            for (int m = 0; m < 4; ++m) { const float inv = inv_from_ss(sq[m]);
#pragma unroll
                for (int bj = 0; bj < 2; ++bj) { const size_t o = off0 + (size_t)m * 16 * 1024 + bj * 32; const u32x4 h2 = hv[m][bj], e2 = ev[m][bj];
                    const f32x4 a0 = acc[ai][bj][m][0] * inv, a1 = acc[ai][bj][m][1] * inv; float ov[8];
                    const unsigned hw[4] = {h2.x, h2.y, h2.z, h2.w}, ew[4] = {e2.x, e2.y, e2.z, e2.w};
#pragma unroll
                    for (int k = 0; k < 4; ++k) { const f32x2 av = (k < 2) ? (f32x2){a0[2 * k], a0[2 * k + 1]} : (f32x2){a1[2 * k - 4], a1[2 * k - 3]};
                        const f32x2 t = av * (-1.4426950408889634f); f32x2 d; d.x = __builtin_amdgcn_exp2f(t.x); d.y = __builtin_amdgcn_exp2f(t.y); d = d + 1.0f;
                        f32x2 sg; sg.x = __builtin_amdgcn_rcpf(d.x); sg.y = __builtin_amdgcn_rcpf(d.y);
                        const f32x2 hh = (f32x2){bf_lo(hw[k]), bf_hi(hw[k])}, ee = (f32x2){bf_lo(ew[k]), bf_hi(ew[k])}; const f32x2 r = hh + sg * ee; ov[2 * k] = r.x; ov[2 * k + 1] = r.y; }
                    u32x4 w; w.x = cvt_pk_bf16(ov[0], ov[1]); w.y = cvt_pk_bf16(ov[2], ov[3]); w.z = cvt_pk_bf16(ov[4], ov[5]); w.w = cvt_pk_bf16(ov[6], ov[7]);
                    *(u32x4*)(out + o) = w; } }
            asm volatile("" ::: "memory"); __builtin_amdgcn_sched_barrier(0);
        }
    }
};

#define DPPR(src_, ctrl_) __uint_as_float((unsigned)__builtin_amdgcn_update_dpp(0, (int)__float_as_uint(src_), ctrl_, 0xf, 0xf, true))
#define DPPF(old_, src_, ctrl_) __uint_as_float((unsigned)__builtin_amdgcn_update_dpp((int)__float_as_uint(old_), (int)__float_as_uint(src_), ctrl_, 0xf, 0xf, false))
struct EpiConv {
    static constexpr bool PERM = true, AFTER_DRAIN = false;
    const float* ss_in; const float* cw; const float* cb; bf16_t* act; float* halo;
    __device__ __forceinline__ void operator()(f32x4 (&acc)[2][2][4][2], const Unit& u, int wr, int wc, int fr_, int fq_, PG8_LAS unsigned char* lds) const {
        int fr = fr_, fq = fq_; asm volatile("" : "+v"(fr), "+v"(fq));
        PG8_LAS float* X = (PG8_LAS float*)(lds + 131072);
        f32x4 cA[2][4];
#pragma unroll
        for (int bj = 0; bj < 2; ++bj) { const int c = bj * 2816 + u.pn * 128 + wc * 32 + 8 * fq; cA[bj][0] = *(const f32x4*)(cw + c); cA[bj][1] = *(const f32x4*)(cw + 5632 + c); cA[bj][2] = *(const f32x4*)(cw + 2 * 5632 + c); cA[bj][3] = *(const f32x4*)(cb + c); }
        { float sq[2][4];
#pragma unroll
          for (int ai = 0; ai < 2; ++ai)
#pragma unroll
              for (int m = 0; m < 4; ++m) sq[ai][m] = ss_in[u.pm * BM + ai * HALF + wr * 64 + m * 16 + fr];
#pragma unroll
          for (int ai = 0; ai < 2; ++ai)
#pragma unroll
              for (int m = 0; m < 4; ++m) { const float inv = inv_from_ss(sq[ai][m]);
#pragma unroll
                  for (int bj = 0; bj < 2; ++bj)
#pragma unroll
                      for (int n = 0; n < 2; ++n) acc[ai][bj][m][n] = acc[ai][bj][m][n] * inv; }
          asm volatile("" ::: "memory"); __builtin_amdgcn_sched_barrier(0); }
        if (fr >= 14) {
#pragma unroll
            for (int ai = 0; ai < 2; ++ai) { const int xb = (((((wr * 2 + ai) * 4 + wc) * 2 + (fr - 14)) * 4) + fq) * 16;
#pragma unroll
                for (int bj = 0; bj < 2; ++bj)
#pragma unroll
                    for (int n = 0; n < 2; ++n) *(PG8_LAS f32x4*)(X + xb + bj * 8 + n * 4) = acc[ai][bj][3][n]; }
            if (wr == 1) { float* hp = halo + ((size_t)(u.pm * 4 + 2 + (fr - 14)) * 22 + u.pn) * 256 + wc * 32 + 8 * fq;
#pragma unroll
                for (int bj = 0; bj < 2; ++bj)
#pragma unroll
                    for (int n = 0; n < 2; ++n) *(f32x4*)(hp + bj * 128 + 4 * n) = acc[1][bj][3][n]; }
        }
        if (fr < 2 && wr == 0) { float* hp = halo + ((size_t)(u.pm * 4 + fr) * 22 + u.pn) * 256 + wc * 32 + 8 * fq;
#pragma unroll
            for (int bj = 0; bj < 2; ++bj)
#pragma unroll
                for (int n = 0; n < 2; ++n) *(f32x4*)(hp + bj * 128 + 4 * n) = acc[0][bj][0][n]; }
        asm volatile("s_waitcnt lgkmcnt(0)" ::: "memory"); __builtin_amdgcn_s_barrier(); asm volatile("" ::: "memory");
        const int pwr = wr ^ 1;
        u32x2 stash[2][4];
        auto grp = [&](const int n, const int ai, const f32x4 (&C)[2][4]) __attribute__((always_inline)) {
            const int gc = u.pn * 128 + wc * 32 + 8 * fq + 4 * n;
#pragma unroll
            for (int m = 0; m < 4; ++m) {
                int r = u.pm * BM + ai * HALF + wr * 64 + m * 16 + fr; asm volatile("" : "+v"(r));
                f32x4 y[2];
#pragma unroll
                for (int bj = 0; bj < 2; ++bj) {
                    const f32x4 U = acc[ai][bj][m][n]; f32x4 t1, t2;
                    if (m == 0) {
                        if (ai == 0 && wr == 0) { t1 = (f32x4){0.f, 0.f, 0.f, 0.f}; t2 = t1; }
                        else { const int pai = (wr == 1) ? ai : 0; const int xb = ((((pwr * 2 + pai) * 4 + wc) * 2) * 4 + fq) * 16 + bj * 8 + n * 4;
                            t1 = *(const PG8_LAS f32x4*)(X + xb + 64); t2 = *(const PG8_LAS f32x4*)(X + xb + (fr == 0 ? 0 : 64)); }
                    } else { const f32x4 Up = acc[ai][bj][m - 1][n];
#pragma unroll
                        for (int e = 0; e < 4; ++e) { t1[e] = DPPR(Up[e], 0x121); t2[e] = DPPR(Up[e], 0x122); } }
                    f32x4 P1, P2;
#pragma unroll
                    for (int e = 0; e < 4; ++e) { P1[e] = DPPF(t1[e], U[e], 0x111); P2[e] = DPPF(t2[e], U[e], 0x112); }
                    y[bj] = C[bj][0] * P2 + C[bj][1] * P1 + C[bj][2] * U + C[bj][3];
                    __builtin_amdgcn_sched_barrier(0);
                }
                f32x4 a;
#pragma unroll
                for (int e = 0; e < 4; e += 2) { const f32x2 gt = (f32x2){y[0][e], y[0][e + 1]}, vl = (f32x2){y[1][e], y[1][e + 1]}; const f32x2 t = gt * (-1.4426950408889634f);
                    f32x2 d; d.x = __builtin_amdgcn_exp2f(t.x); d.y = __builtin_amdgcn_exp2f(t.y); d = d + 1.0f; f32x2 r; r.x = __builtin_amdgcn_rcpf(d.x); r.y = __builtin_amdgcn_rcpf(d.y);
                    const f32x2 o2 = (gt * vl) * r; a[e] = o2.x; a[e + 1] = o2.y; }
                u32x2 w; w.x = cvt_pk_bf16(a[0], a[1]); w.y = cvt_pk_bf16(a[2], a[3]);
                if (n == 0) stash[ai][m] = w;
                else { u32x4 w16; w16.x = stash[ai][m].x; w16.y = stash[ai][m].y; w16.z = w.x; w16.w = w.y; *(u32x4*)(act + (size_t)r * 2816 + gc - 4) = w16; }
                __builtin_amdgcn_sched_barrier(0);
            }
        };
        grp(0, 0, cA);
        f32x4 cB[2][4];
#pragma unroll
        for (int bj = 0; bj < 2; ++bj) { const int c = bj * 2816 + u.pn * 128 + wc * 32 + 8 * fq + 4; cB[bj][0] = *(const f32x4*)(cw + c); cB[bj][1] = *(const f32x4*)(cw + 5632 + c); cB[bj][2] = *(const f32x4*)(cw + 2 * 5632 + c); cB[bj][3] = *(const f32x4*)(cb + c); }
        grp(0, 1, cA);
        grp(1, 0, cB);
        grp(1, 1, cB);
    }
};
template <class E, class = void> struct EpiLine { static constexpr bool value = false; };
template <class E> struct EpiLine<E, decltype((void)E::LINE)> { static constexpr bool value = E::LINE; };
template <class Epi, class Sched, bool ALIGN_EPI = false, bool SP2 = false>
__device__ __forceinline__ void gemm_phase(PG8_LAS unsigned char* lds, const Gemm g, const Sched& S, const Epi& E) {
    int tid_ = threadIdx.x; asm volatile("" : "+v"(tid_));
    const int tid = tid_, wid = __builtin_amdgcn_readfirstlane(tid >> 6), lane = tid & 63, wr = wid >> 2, wc = wid & 3, fr = lane & 15, fq = lane >> 4;
    const int K = g.K, nt = K / BK;
    unsigned voffA[2], voffB[2];
#pragma unroll
    for (int i = 0; i < 2; ++i) { int R, C; stage_rc(tid * 16 + i * 8192, R, C); const int Rb = EpiLine<Epi>::value ? (64 * (R >> 5) + perm32(R & 31)) : (Epi::PERM ? ((R & ~31) + perm32(R & 31)) : R);
        voffA[i] = (unsigned)(R * K + C) * 2u; voffB[i] = (unsigned)(Rb * K + C) * 2u; }
    const size_t kstep = (size_t)(BK * 2);
    const size_t hstep = (size_t)HALF * K * 2;
    const size_t tstep = 2 * hstep;
    const size_t hstepB = EpiLine<Epi>::value ? (size_t)32 * K * 2 : hstep;
    const unsigned ldsw = (unsigned)wid * 1024u;
    const int aoff = lds_byte(wr * 64 + fr, fq * 8), boff = lds_byte(wc * 32 + fr, fq * 8);
#define PG8_SA(b, h) (((b) * 2 + (h)) * HTB)
#define PG8_SB(b, h) ((4 + (b) * 2 + (h)) * HTB)
#define PG8_STAGE(bufoff, gbase, voff) do { _Pragma("unroll") for (int _i = 0; _i < 2; ++_i) \
        __builtin_amdgcn_global_load_lds((const unsigned*)((const char*)(gbase) + (voff)[_i]), (PG8_LAS unsigned*)(lds + (bufoff) + ldsw + _i * 8192), 16, 0, 0); } while (0)
#define PG8_LDA(dst, b, h) do { _Pragma("unroll") for (int m = 0; m < 4; ++m) _Pragma("unroll") for (int k = 0; k < 2; ++k) dst[m][k] = *(const PG8_LAS bf16x8*)(lds + PG8_SA(b, h) + aoff + m * 2048 + k * 1024); } while (0)
#define PG8_LDB(dst, b, h) do { _Pragma("unroll") for (int n = 0; n < 2; ++n) _Pragma("unroll") for (int k = 0; k < 2; ++k) dst[n][k] = *(const PG8_LAS bf16x8*)(lds + PG8_SB(b, h) + boff + n * 2048 + k * 1024); } while (0)
#define PG8_MMA(ai, bj, At, Bt) do { __builtin_amdgcn_s_setprio(1); _Pragma("unroll") for (int m = 0; m < 4; ++m) _Pragma("unroll") for (int n = 0; n < 2; ++n) _Pragma("unroll") for (int k = 0; k < 2; ++k) \
        acc[ai][bj][m][n] = __builtin_amdgcn_mfma_f32_16x16x32_bf16(Bt[n][k], At[m][k], acc[ai][bj][m][n], 0, 0, 0); __builtin_amdgcn_s_setprio(0); } while (0)
#define PG8_WAIT_V(n) asm volatile("s_waitcnt vmcnt(" #n ")" ::: "memory")
#define PG8_WAIT_L(n) asm volatile("s_waitcnt lgkmcnt(" #n ")" ::: "memory")
#define PG8_BAR __builtin_amdgcn_s_barrier()
#define PG8_SCHED __builtin_amdgcn_sched_barrier(0)
    Unit cur, nxt; int ui = 0;
    if (!S.next(0, cur)) return;
    f32x4 acc[2][2][4][2];
#pragma unroll
    for (int a = 0; a < 2; ++a)
#pragma unroll
        for (int b = 0; b < 2; ++b)
#pragma unroll
            for (int m = 0; m < 4; ++m)
#pragma unroll
                for (int n = 0; n < 2; ++n) acc[a][b][m][n] = (f32x4){0.f, 0.f, 0.f, 0.f};
    bf16x8 At[4][2], B0[2][2], B1[2][2];
    const char* cA = (const char*)g.A + (size_t)cur.pm * tstep; const char* cB = (const char*)g.Bt + (size_t)cur.pn * tstep;
    S.a_ready(cur);
    if constexpr (SP2) {
        PG8_STAGE(PG8_SB(0, 0), cB, voffB); PG8_STAGE(PG8_SB(0, 1), cB + hstepB, voffB); PG8_STAGE(PG8_SA(0, 0), cA, voffA); PG8_STAGE(PG8_SA(0, 1), cA + hstep, voffA);
        if (wr == 1) PG8_BAR;
        PG8_WAIT_V(2); PG8_BAR;
        PG8_STAGE(PG8_SB(1, 0), cB + kstep, voffB); PG8_STAGE(PG8_SA(1, 0), cA + kstep, voffA); PG8_STAGE(PG8_SB(1, 1), cB + hstepB + kstep, voffB);
        PG8_WAIT_V(6); PG8_BAR;
    } else {
        PG8_STAGE(PG8_SB(0, 0), cB, voffB); PG8_STAGE(PG8_SA(0, 0), cA, voffA); PG8_STAGE(PG8_SB(0, 1), cB + hstepB, voffB); PG8_STAGE(PG8_SA(0, 1), cA + hstep, voffA);
        if (wr == 1) PG8_BAR;
        PG8_WAIT_V(4); PG8_BAR;
        PG8_STAGE(PG8_SB(1, 0), cB + kstep, voffB); PG8_STAGE(PG8_SA(1, 0), cA + kstep, voffA); PG8_STAGE(PG8_SB(1, 1), cB + hstepB + kstep, voffB);
        PG8_WAIT_V(6); PG8_BAR;
    }
    for (;;) {
        const bool has_next = S.next(ui + 1, nxt);
        const char* nA = has_next ? (const char*)g.A + (size_t)nxt.pm * tstep : cA; const char* nB = has_next ? (const char*)g.Bt + (size_t)nxt.pn * tstep : cB;
        for (int t = 0; t < nt; t += 2) {
            const bool last = (t == nt - 2);
            const char* a1 = cA + (size_t)(t + 1) * kstep;
            const char* a2 = last ? nA : cA + (size_t)(t + 2) * kstep; const char* b2 = last ? nB : cB + (size_t)(t + 2) * kstep;
            const char* a3 = a2 + kstep; const char* b3 = b2 + kstep;
            if (last && has_next) S.a_ready(nxt);
            if constexpr (SP2) {
            PG8_LDB(B0, 0, 0); PG8_LDB(B1, 0, 1); PG8_SCHED; PG8_LDA(At, 0, 0); PG8_STAGE(PG8_SA(1, 1), a1 + hstep, voffA);
            PG8_WAIT_V(8); PG8_WAIT_L(0); PG8_BAR; PG8_MMA(0, 0, At, B0); PG8_MMA(0, 1, At, B1); PG8_BAR; PG8_SCHED;
            PG8_LDA(At, 0, 1); PG8_STAGE(PG8_SB(0, 0), b2, voffB); PG8_STAGE(PG8_SB(0, 1), b2 + hstepB, voffB); PG8_STAGE(PG8_SA(0, 0), a2, voffA);
            PG8_WAIT_V(8); PG8_WAIT_L(0); PG8_BAR; PG8_MMA(1, 0, At, B0); PG8_MMA(1, 1, At, B1); PG8_BAR; PG8_SCHED;
            PG8_LDB(B0, 1, 0); PG8_LDB(B1, 1, 1); PG8_SCHED; PG8_LDA(At, 1, 0); PG8_STAGE(PG8_SA(0, 1), a2 + hstep, voffA);
            PG8_WAIT_V(8); PG8_WAIT_L(0); PG8_BAR; PG8_MMA(0, 0, At, B0); PG8_MMA(0, 1, At, B1); PG8_BAR; PG8_SCHED;
            PG8_LDA(At, 1, 1); PG8_STAGE(PG8_SB(1, 0), b3, voffB); PG8_STAGE(PG8_SB(1, 1), b3 + hstepB, voffB); PG8_STAGE(PG8_SA(1, 0), a3, voffA);
            PG8_WAIT_V(8); PG8_WAIT_L(0); PG8_BAR; PG8_MMA(1, 0, At, B0); PG8_MMA(1, 1, At, B1); PG8_BAR; PG8_SCHED;
            } else {
            PG8_LDB(B0, 0, 0); PG8_SCHED; PG8_LDA(At, 0, 0); PG8_STAGE(PG8_SA(1, 1), a1 + hstep, voffA);
            PG8_WAIT_L(8); PG8_BAR; PG8_WAIT_L(0); PG8_MMA(0, 0, At, B0); PG8_BAR; PG8_SCHED;
            PG8_LDB(B1, 0, 1); PG8_STAGE(PG8_SB(0, 0), b2, voffB);
            PG8_BAR; PG8_WAIT_L(0); PG8_MMA(0, 1, At, B1); PG8_BAR;
            PG8_LDA(At, 0, 1); PG8_STAGE(PG8_SA(0, 0), a2, voffA);
            PG8_BAR; PG8_WAIT_L(0); PG8_MMA(1, 0, At, B0); PG8_BAR; PG8_SCHED;
            PG8_STAGE(PG8_SB(0, 1), b2 + hstepB, voffB);
            PG8_WAIT_V(6); PG8_BAR; PG8_MMA(1, 1, At, B1); PG8_BAR;
            PG8_LDB(B0, 1, 0); PG8_SCHED; PG8_LDA(At, 1, 0); PG8_STAGE(PG8_SA(0, 1), a2 + hstep, voffA);
            PG8_WAIT_L(8); PG8_BAR; PG8_WAIT_L(0); PG8_MMA(0, 0, At, B0); PG8_BAR; PG8_SCHED;
            PG8_LDB(B1, 1, 1); PG8_STAGE(PG8_SB(1, 0), b3, voffB);
            PG8_BAR; PG8_WAIT_L(0); PG8_MMA(0, 1, At, B1); PG8_BAR;
            PG8_LDA(At, 1, 1); PG8_STAGE(PG8_SA(1, 0), a3, voffA);
            PG8_BAR; PG8_WAIT_L(0); PG8_MMA(1, 0, At, B0); PG8_BAR; PG8_SCHED;
            PG8_STAGE(PG8_SB(1, 1), b3 + hstepB, voffB);
            PG8_WAIT_V(6); PG8_BAR; PG8_MMA(1, 1, At, B1); PG8_BAR;
            }
        }
        if constexpr (ALIGN_EPI) { if (wr == 0) PG8_BAR; }
        if constexpr (!Epi::AFTER_DRAIN) { E(acc, cur, wr, wc, fr, fq, lds); S.done(cur); }
        if (!has_next) break;
#pragma unroll
        for (int a = 0; a < 2; ++a)
#pragma unroll
            for (int b = 0; b < 2; ++b)
#pragma unroll
                for (int m = 0; m < 4; ++m)
#pragma unroll
                    for (int n = 0; n < 2; ++n) acc[a][b][m][n] = (f32x4){0.f, 0.f, 0.f, 0.f};
        cur = nxt; cA = nA; cB = nB; ++ui;
        if constexpr (ALIGN_EPI) { if (wr == 1) PG8_BAR; }
    }
    PG8_WAIT_V(0);
    if constexpr (!ALIGN_EPI) { if (wr == 0) PG8_BAR; }
    PG8_BAR;
    if constexpr (Epi::AFTER_DRAIN) { E.fused(acc, cur, wr, wc, fr, fq, lds, wid, lane); S.done(cur); }
#undef PG8_SA
#undef PG8_SB
#undef PG8_STAGE
#undef PG8_LDA
#undef PG8_LDB
#undef PG8_MMA
#undef PG8_WAIT_V
#undef PG8_WAIT_L
#undef PG8_BAR
#undef PG8_SCHED
}
}
constexpr int NB = 8, SEQ = 4096, MT = NB * SEQ, DM = 1024, NZ = 2048, FF = 2816, NUP = 5632, PLE = 256;
constexpr int NWAVES = 8;
constexpr size_t MiB = 1u << 20;
constexpr size_t WS_WIN = 1 * MiB, WS_WO = 5 * MiB, WS_WUP = 7 * MiB, WS_WDN = 19 * MiB, WS_WG = 25 * MiB, WS_WPLE = 27 * MiB;
constexpr size_t WS_XN = 32 * MiB;
constexpr size_t WS_PB = 96 * MiB;
constexpr size_t WS_E = 112 * MiB;
constexpr size_t WS_Z = 176 * MiB;
constexpr size_t WS_OP = 304 * MiB;
constexpr size_t WS_ML = 400 * MiB;
constexpr size_t WS_MIX = 406 * MiB;
constexpr size_t WS_HALO = 470 * MiB;
constexpr size_t WS_SS1 = 482 * MiB, WS_SS2 = WS_SS1 + (size_t)MT * 4, WS_RI = WS_SS2 + (size_t)MT * 4;
constexpr size_t WS_ACT = 176 * MiB;
constexpr size_t WS_END = 488 * MiB;
static_assert(WS_ACT + (size_t)MT * FF * 2 <= WS_MIX, "act overlay");
constexpr int LDS_BYTES = 147456;
#define LAS __attribute__((address_space(3)))
typedef unsigned short bf16;
typedef unsigned v4u __attribute__((ext_vector_type(4)));
typedef unsigned v2u __attribute__((ext_vector_type(2)));
typedef float f32x4 __attribute__((ext_vector_type(4)));
typedef float f32x16 __attribute__((ext_vector_type(16)));
typedef short bf16x8 __attribute__((ext_vector_type(8)));
#define LDS_WAIT() asm volatile("s_waitcnt lgkmcnt(0)" ::: "memory")
__device__ __forceinline__ unsigned pk2(float lo, float hi) { return pg8::cvt_pk_bf16(lo, hi); }
__device__ __forceinline__ float blo(unsigned w) { return __uint_as_float(w << 16); }
__device__ __forceinline__ float bhi(unsigned w) { return __uint_as_float(w & 0xffff0000u); }
__device__ __forceinline__ float wave_sum(float v) {
#pragma unroll
    for (int o = 1; o < 64; o <<= 1) v += __shfl_xor(v, o);
    return v;
}

__device__ __forceinline__ void tr_fill(const float* W, int ldw, int k0, int c0, const float* kscale, float mul, LAS float* scr, int lane) {
    const int c4 = (lane & 7) * 4;
    f32x4 v[8];
#pragma unroll
    for (int i = 0; i < 8; ++i) v[i] = __builtin_nontemporal_load((const f32x4*)(W + (size_t)(k0 + (lane >> 3) + 8 * i) * ldw + c0 + c4));
#pragma unroll
    for (int i = 0; i < 8; ++i) { const int kk = (lane >> 3) + 8 * i; const float sc = kscale ? kscale[k0 + kk] * mul : mul;
        scr[kk * 33 + c4 + 0] = v[i].x * sc; scr[kk * 33 + c4 + 1] = v[i].y * sc; scr[kk * 33 + c4 + 2] = v[i].z * sc; scr[kk * 33 + c4 + 3] = v[i].w * sc; }
    LDS_WAIT(); asm volatile("" ::: "memory");
}
__device__ __forceinline__ void tr_write(bf16* WT, int ldt, int row0, int kd0, LAS float* scr, int lane) {
    const int c = lane & 7;
#pragma unroll
    for (int j = 0; j < 4; ++j) { const int n = (lane >> 3) + 8 * j; const LAS float* s = scr + (8 * c) * 33 + n;
        v4u o; o.x = pk2(s[0 * 33], s[1 * 33]); o.y = pk2(s[2 * 33], s[3 * 33]); o.z = pk2(s[4 * 33], s[5 * 33]); o.w = pk2(s[6 * 33], s[7 * 33]);
        *(v4u*)(WT + (size_t)(row0 + n) * ldt + kd0 + 8 * c) = o; }
    LDS_WAIT(); asm volatile("" ::: "memory");
}
__device__ __forceinline__ void weff_item(const float* pool_w, const float* pool_scale, const float* w_out, bf16* WT, int g, int c8, int n0, int lane) {
    const int n = lane & 31, half = lane >> 5;
    float acc[4] = {0.f, 0.f, 0.f, 0.f};
    const float* pw = pool_w + ((size_t)(g * 128 + c8 * 8 + half * 4)) * 128;
    const float* wo = w_out + (size_t)(512 + g * 128) * 1024 + n0 + n;
    const float* ps = pool_scale + g * 128;
#pragma unroll 4
    for (int e = 0; e < 128; e += 4) {
        const f32x4 sc = *(const f32x4*)(ps + e);
        const float w0 = wo[(size_t)(e + 0) * 1024] * sc.x, w1 = wo[(size_t)(e + 1) * 1024] * sc.y, w2 = wo[(size_t)(e + 2) * 1024] * sc.z, w3 = wo[(size_t)(e + 3) * 1024] * sc.w;
#pragma unroll
        for (int i = 0; i < 4; ++i) { const f32x4 p = *(const f32x4*)(pw + (size_t)i * 128 + e); acc[i] += (p.x * w0 + p.y * w1) + (p.z * w2 + p.w * w3); }
    }
    v2u o; o.x = pk2(acc[0], acc[1]); o.y = pk2(acc[2], acc[3]);
    *(v2u*)(WT + (size_t)(n0 + n) * 1024 + 512 + g * 128 + c8 * 8 + half * 4) = o;
}

struct Args { const float* in[16]; float* out; unsigned char* ws; int ph_lo, ph_hi; };
typedef __attribute__((address_space(4))) const unsigned char* kptr_t;
__device__ __forceinline__ kptr_t kargs_base() { kptr_t p = (kptr_t)__builtin_amdgcn_kernarg_segment_ptr(); asm volatile("" : "+s"(p)); return p; }
__device__ __forceinline__ unsigned long long karg_u64(int off) { return *(const __attribute__((address_space(4))) unsigned long long*)(kargs_base() + off); }
#define GAS1 __attribute__((address_space(1)))
__device__ __forceinline__ const float* karg_in(int i) { return (const float*)(const GAS1 float*)karg_u64(8 * i); }
__device__ __forceinline__ float* karg_out() { return (float*)(GAS1 float*)karg_u64(128); }
__device__ __forceinline__ unsigned char* karg_ws() { return (unsigned char*)(GAS1 unsigned char*)karg_u64(136); }
__device__ __forceinline__ int karg_i32(int off) { return *(const __attribute__((address_space(4))) int*)(kargs_base() + off); }

__device__ __forceinline__ void p0_prologue(unsigned char* ws, LAS unsigned char* lds, int gw, int NGW, int gws, int lane, int wave) {
    LAS float* scr = (LAS float*)(lds + wave * 16384);
    const float* w_in = karg_in(3); const float* pool_w = karg_in(4); const float* pool_scale = karg_in(5); const float* w_out = karg_in(6); const float* ln_ffn = karg_in(7);
    const float* w_up = karg_in(8); const float* w_down = karg_in(11); const float* ln_ple = karg_in(12); const float* w_g = karg_in(13); const float* w_ple = karg_in(14);
    constexpr int I_IN = 16 * 64, I_OT = 8 * 32, I_EFF = 4 * 16 * 32, I_UP = 16 * 176, I_DN = 44 * 32, I_G = 16 * 32, I_PLE = 4 * 32;
    constexpr int NITEMS = I_IN + I_OT + I_EFF + I_UP + I_DN + I_G + I_PLE;
    for (int it = gws; it < NITEMS; it += NGW) {
        int r = it;
        if (r < I_EFF) { const int g = r >> 9, c8 = (r >> 5) & 15, nb = r & 31; weff_item(pool_w, pool_scale, w_out, (bf16*)(ws + WS_WO), g, c8, nb * 32, lane); continue; } r -= I_EFF;
        if (r < I_IN) { const int kb = r >> 6, nb = r & 63; tr_fill(w_in, NZ, kb * 64, nb * 32, karg_in(2), nb < 16 ? 0.125f * 1.4426950408889634f : 1.0f, scr, lane); tr_write((bf16*)(ws + WS_WIN), 1024, nb * 32, kb * 64, scr, lane); continue; } r -= I_IN;
        if (r < I_OT) { const int kb = r >> 5, nb = r & 31; tr_fill(w_out, 1024, kb * 64, nb * 32, nullptr, 1.0f, scr, lane); tr_write((bf16*)(ws + WS_WO), 1024, nb * 32, kb * 64, scr, lane); continue; } r -= I_OT;
        if (r < I_UP) { const int kb = r / 176, nb = r % 176; const int n0 = nb * 32, pn = n0 >> 8, bj = (n0 >> 7) & 1, j = n0 & 127;
            tr_fill(w_up, NUP, kb * 64, bj * FF + pn * 128 + j, ln_ffn, 1.0f, scr, lane); tr_write((bf16*)(ws + WS_WUP), 1024, n0, kb * 64, scr, lane); continue; } r -= I_UP;
        if (r < I_DN) { const int kb = r >> 5, nb = r & 31; tr_fill(w_down, 1024, kb * 64, nb * 32, nullptr, 1.0f, scr, lane); tr_write((bf16*)(ws + WS_WDN), FF, nb * 32, kb * 64, scr, lane); continue; } r -= I_DN;
        if (r < I_G) { const int kb = r >> 5, nb = r & 31; tr_fill(w_g, 1024, kb * 64, nb * 32, ln_ple, 1.0f, scr, lane); tr_write((bf16*)(ws + WS_WG), 1024, nb * 32, kb * 64, scr, lane); continue; } r -= I_G;
        { const int kb = r >> 5, nb = r & 31; tr_fill(w_ple, 1024, kb * 64, nb * 32, nullptr, 1.0f, scr, lane); tr_write((bf16*)(ws + WS_WPLE), PLE, nb * 32, kb * 64, scr, lane); }
    }
    { float* ssz = (float*)(ws + WS_SS1); for (int i = gw * 64 + lane; i < 2 * MT; i += NGW * 64) ssz[i] = 0.f; }
    const float* x = karg_in(0); const float* lnm = karg_in(2); bf16* XN = (bf16*)(ws + WS_XN);
    f32x4 g[4];
#pragma unroll
    for (int j = 0; j < 4; ++j) g[j] = ((const f32x4*)lnm)[lane + 64 * j];
    for (int m = gw; m < MT; m += 2 * NGW) {
        const int m2 = (m + NGW) < MT ? (m + NGW) : (MT - 1);
        const f32x4* xr = (const f32x4*)(x + (size_t)m * DM) + lane; const f32x4* xr2 = (const f32x4*)(x + (size_t)m2 * DM) + lane; f32x4 v[4], u[4]; float s = 0.f, s2 = 0.f;
#pragma unroll
        for (int j = 0; j < 4; ++j) { v[j] = __builtin_nontemporal_load(xr + 64 * j); u[j] = __builtin_nontemporal_load(xr2 + 64 * j); }
#pragma unroll
        for (int j = 0; j < 4; ++j) { s += (v[j].x * v[j].x + v[j].y * v[j].y) + (v[j].z * v[j].z + v[j].w * v[j].w); s2 += (u[j].x * u[j].x + u[j].y * u[j].y) + (u[j].z * u[j].z + u[j].w * u[j].w); }
        const float inv = 1.0f / sqrtf(wave_sum(s) * (1.0f / DM) + 1e-6f), inv2 = 1.0f / sqrtf(wave_sum(s2) * (1.0f / DM) + 1e-6f);
        if (lane == 0) { float* RI = (float*)(ws + WS_RI); RI[m] = inv; RI[m2] = inv2; }
        v2u* o8 = (v2u*)(XN + (size_t)m * DM) + lane; v2u* o82 = (v2u*)(XN + (size_t)m2 * DM) + lane;
#pragma unroll
        for (int j = 0; j < 4; ++j) { v2u w; w.x = pk2(v[j].x, v[j].y); w.y = pk2(v[j].z, v[j].w); o8[64 * j] = w;
            v2u w2; w2.x = pk2(u[j].x, u[j].y); w2.y = pk2(u[j].z, u[j].w); o82[64 * j] = w2; }
    }
    const float* p = karg_in(1); bf16* PB = (bf16*)(ws + WS_PB);
    for (int m = gw; m < MT; m += 4 * NGW) { f32x4 v[4];
#pragma unroll
        for (int j = 0; j < 4; ++j) { const int mj = (m + j * NGW) < MT ? (m + j * NGW) : (MT - 1); v[j] = __builtin_nontemporal_load((const f32x4*)(p + (size_t)mj * PLE) + lane); }
#pragma unroll
        for (int j = 0; j < 4; ++j) { v2u w; w.x = pk2(v[j].x, v[j].y); w.y = pk2(v[j].z, v[j].w); const int mj = (m + j * NGW) < MT ? (m + j * NGW) : (MT - 1); ((v2u*)(PB + (size_t)mj * PLE))[lane] = w; } }
}

__device__ __forceinline__ float other_half(float v) { const auto r = __builtin_amdgcn_permlane32_swap(__float_as_uint(v), __float_as_uint(v), false, false); const unsigned o = (__lane_id() < 32) ? r[1] : r[0]; return __uint_as_float(o); }
__device__ __forceinline__ float max_halves(float v) { const auto r = __builtin_amdgcn_permlane32_swap(__float_as_uint(v), __float_as_uint(v), false, false); return fmaxf(__uint_as_float(r[0]), __uint_as_float(r[1])); }
__device__ __forceinline__ float sum_halves(float v) { const auto r = __builtin_amdgcn_permlane32_swap(__float_as_uint(v), __float_as_uint(v), false, false); return __uint_as_float(r[0]) + __uint_as_float(r[1]); }
__device__ __forceinline__ int crow(int r, int hi) { return (r & 3) + 8 * (r >> 2) + 4 * hi; }
struct AttnIt { int p, h, lsh, r, a0; size_t tokbase; };
__device__ __forceinline__ AttnIt attn_decode(int it) {
    AttnIt A; const int bh = it / 48, rem = it % 48, j = rem & 15; A.p = rem >> 4; A.h = bh & 7; A.lsh = 2 * A.p;
    int chunk; if (A.p == 0) { A.r = 0; chunk = j; } else if (A.p == 1) { A.r = j >> 2; chunk = j & 3; } else { A.r = j; chunk = 0; }
    A.a0 = chunk * 256; A.tokbase = (size_t)(bh >> 3) * SEQ; return A;
}
__device__ __forceinline__ void attn_prefetch(const bf16* Z, const AttnIt& A, int tid, v4u (&kr)[6], v4u (&vr)[6], bf16x8 (&qf)[4]) {
    const unsigned tb = (unsigned)A.tokbase, r = (unsigned)A.r, lsh = (unsigned)A.lsh, hc = (unsigned)A.h * 64u;
#pragma unroll
    for (int i = 0; i < 6; ++i) { const int id = tid + 512 * i, key = id >> 3, pc = id & 7, a = A.a0 - 128 + key; const unsigned ac = a < 0 ? 0u : (unsigned)a;
        kr[i] = *(const v4u*)(Z + ((tb + (ac << lsh) + r) * (unsigned)NZ + 512u + hc + (unsigned)pc * 8u)); }
#pragma unroll
    for (int i = 0; i < 3; ++i) { const int id = tid + 512 * i, pc = id & 7, kp = id >> 3, a = A.a0 - 128 + 2 * kp; const unsigned ac = a < 0 ? 0u : (unsigned)a;
        vr[2 * i] = *(const v4u*)(Z + ((tb + (ac << lsh) + r) * (unsigned)NZ + 1024u + hc + (unsigned)pc * 8u)); vr[2 * i + 1] = *(const v4u*)(Z + ((tb + ((ac + 1u) << lsh) + r) * (unsigned)NZ + 1024u + hc + (unsigned)pc * 8u)); }
    const int w = tid >> 6, lane = tid & 63, q = lane & 31, hi = lane >> 5; const unsigned aq = (unsigned)(A.a0 + 32 * w + q); const unsigned tq = tb + (aq << lsh) + r;
#pragma unroll
    for (int s = 0; s < 4; ++s) qf[s] = *(const bf16x8*)(Z + (tq * (unsigned)NZ + hc + 16u * s + 8u * hi));
}
__device__ __forceinline__ void attn_stage(LAS unsigned char* lds, int tid, const v4u (&kr)[6], const v4u (&vr)[6]) {
    LAS bf16* Ks = (LAS bf16*)lds; LAS unsigned* vt32 = (LAS unsigned*)(lds + 384 * 72 * 2);
#pragma unroll
    for (int i = 0; i < 6; ++i) { const int id = tid + 512 * i, key = id >> 3, pc = id & 7; *(LAS v4u*)(Ks + key * 72 + pc * 8) = kr[i]; }
#pragma unroll
    for (int i = 0; i < 3; ++i) { const int id = tid + 512 * i, pc = id & 7, kp = id >> 3;
        const int k16 = (2 * kp) & 15, kpos = ((2 * kp) & ~15) + ((k16 < 4 || k16 >= 12) ? k16 : (k16 < 8 ? k16 + 4 : k16 - 4));
#pragma unroll
        for (int e2 = 0; e2 < 4; ++e2) { const unsigned w0 = vr[2 * i][e2], w1 = vr[2 * i + 1][e2];
            vt32[((pc * 8 + 2 * e2) * 392 + ((((kpos >> 3) ^ pc) << 3) | (kpos & 7))) >> 1] = (w0 & 0xffffu) | (w1 << 16);
            vt32[((pc * 8 + 2 * e2 + 1) * 392 + ((((kpos >> 3) ^ pc) << 3) | (kpos & 7))) >> 1] = (w0 >> 16) | (w1 & 0xffff0000u); } }
}
__device__ __forceinline__ void attn_compute(LAS unsigned char* lds, bf16* OP, float* ML, const AttnIt& A, int tid, const bf16x8 (&qf)[4]) {
    const int p = A.p, h = A.h, lsh = A.lsh;
    LAS bf16* Ks = (LAS bf16*)lds;
    LAS bf16* Vt = (LAS bf16*)(lds + 384 * 72 * 2);
    const int w = tid >> 6, lane = tid & 63, q = lane & 31, hi = lane >> 5;
    const int aq = A.a0 + 32 * w + q; const size_t tq = A.tokbase + ((size_t)aq << lsh) + A.r;
    const float slope2 = __builtin_amdgcn_exp2f(-(float)(h + 1)) * (float)(1 << lsh) * 1.4426950408889634f;
    const int dmax = aq < 128 ? aq : 128;
    const bool edge = (A.a0 + 32 * w) < 128;
    float mx = -1e30f, l = 0.f;
    f32x16 o[2];
#pragma unroll
    for (int db = 0; db < 2; ++db)
#pragma unroll
        for (int e = 0; e < 16; ++e) o[db][e] = 0.f;
#pragma unroll 1
    for (int kb = 4; kb >= 0; --kb) {
        const int dbase = 128 - 32 * kb + q - 4 * hi; const float c0 = -slope2 * (float)dbase;
        f32x16 st;
#pragma unroll
        for (int e = 0; e < 16; ++e) st[e] = c0 + slope2 * (float)((e & 3) + 8 * (e >> 2));
#pragma unroll
        for (int s = 0; s < 4; ++s) { const bf16x8 kf = *(const LAS bf16x8*)(Ks + (32 * w + 32 * kb + q) * 72 + 16 * s + 8 * hi); st = __builtin_amdgcn_mfma_f32_32x32x16_bf16(kf, qf[s], st, 0, 0, 0); }
        if (kb == 0 || kb == 4 || edge) {
#pragma unroll
            for (int e = 0; e < 16; ++e) { const int diff = dbase - ((e & 3) + 8 * (e >> 2)); st[e] = ((unsigned)diff <= (unsigned)dmax) ? st[e] : -1e30f; }
        }
        float bm = fmaxf(fmaxf(st[0], st[1]), st[2]);
#pragma unroll
        for (int e = 3; e < 15; e += 2) bm = fmaxf(fmaxf(bm, st[e]), st[e + 1]);
        bm = fmaxf(bm, st[15]);
        bm = max_halves(bm);
        const float mn = fmaxf(mx, bm);
        if (__builtin_amdgcn_ballot_w64(mn > mx)) { const float sc = __builtin_amdgcn_exp2f(mx - mn); l *= sc;
#pragma unroll
            for (int db = 0; db < 2; ++db)
#pragma unroll
                for (int e = 0; e < 16; ++e) o[db][e] *= sc; }
        mx = mn;
        float ls = 0.f;
#pragma unroll
        for (int e = 0; e < 16; ++e) { const float pv = __builtin_amdgcn_exp2f(st[e] - mn); st[e] = pv; ls += pv; }
        l += ls;
#pragma unroll
        for (int s2 = 0; s2 < 2; ++s2) {
            v4u pw; pw.x = pk2(st[8 * s2 + 0], st[8 * s2 + 1]); pw.y = pk2(st[8 * s2 + 2], st[8 * s2 + 3]); pw.z = pk2(st[8 * s2 + 4], st[8 * s2 + 5]); pw.w = pk2(st[8 * s2 + 6], st[8 * s2 + 7]);
            const bf16x8 pf = __builtin_bit_cast(bf16x8, pw);
#pragma unroll
            for (int db = 0; db < 2; ++db) { const bf16x8 vf = *(const LAS bf16x8*)(Vt + (32 * db + q) * 392 + (((4 * w + 4 * kb + 2 * s2 + hi) ^ ((4 * db + (q >> 3)) & 7)) << 3));
                o[db] = __builtin_amdgcn_mfma_f32_32x32x16_bf16(vf, pf, o[db], 0, 0, 0); } }
    }
    l = sum_halves(l);
    const float il = 1.0f / l;
    bf16* op = OP + ((size_t)p * MT + tq) * 512 + h * 64 + 8 * hi;
#pragma unroll
    for (int db = 0; db < 2; ++db)
#pragma unroll
        for (int g4 = 0; g4 < 4; g4 += 2) {
            v2u a, b; a.x = pk2(o[db][4 * g4] * il, o[db][4 * g4 + 1] * il); a.y = pk2(o[db][4 * g4 + 2] * il, o[db][4 * g4 + 3] * il);
            b.x = pk2(o[db][4 * g4 + 4] * il, o[db][4 * g4 + 5] * il); b.y = pk2(o[db][4 * g4 + 6] * il, o[db][4 * g4 + 7] * il);
            { auto r = __builtin_amdgcn_permlane32_swap(a.x, b.x, false, false); a.x = r[0]; b.x = r[1]; }
            { auto r = __builtin_amdgcn_permlane32_swap(a.y, b.y, false, false); a.y = r[0]; b.y = r[1]; }
            v4u w; w.x = a.x; w.y = a.y; w.z = b.x; w.w = b.y;
            *(v4u*)(op + 32 * db + 8 * g4) = w; }
    if (hi == 0) { v2u ml; ml.x = __float_as_uint(mx); ml.y = __float_as_uint(l); *(v2u*)(ML + (((size_t)p * MT + tq) * 8 + h) * 2) = ml; }
}

template <int MODE  > __device__ __forceinline__ void merge_pool(const bf16* Z, const bf16* OP, const float* ML, bf16* MIX, int gtid, int nthr) {
    if (MODE == 1) {
    for (int idx0 = gtid; idx0 < MT * 64; idx0 += 2 * nthr) {
        int id[2]; id[0] = idx0; id[1] = (idx0 + nthr) < MT * 64 ? (idx0 + nthr) : idx0;
        float mm_[2][3], ll_[2][3]; v4u ov[2][3];
#pragma unroll
        for (int k = 0; k < 2; ++k) { const int tok = id[k] >> 6, hh = (id[k] >> 3) & 7, pc = id[k] & 7;
#pragma unroll
            for (int p = 0; p < 3; ++p) { const float* mp = ML + (((size_t)p * MT + tok) * 8 + hh) * 2; const v2u t = *(const v2u*)mp; mm_[k][p] = __uint_as_float(t.x); ll_[k][p] = __uint_as_float(t.y);
                ov[k][p] = __builtin_nontemporal_load((const v4u*)(OP + ((size_t)p * MT + tok) * 512 + hh * 64 + pc * 8)); } }
#pragma unroll
        for (int k = 0; k < 2; ++k) { const int tok = id[k] >> 6, hh = (id[k] >> 3) & 7, pc = id[k] & 7;
            const float mm = fmaxf(mm_[k][0], fmaxf(mm_[k][1], mm_[k][2])); float wgt[3], wsum = 0.f;
#pragma unroll
            for (int p = 0; p < 3; ++p) { wgt[p] = ll_[k][p] * __builtin_amdgcn_exp2f(mm_[k][p] - mm); wsum += wgt[p]; }
            const float iw = 1.0f / wsum; float acc[8];
#pragma unroll
            for (int e = 0; e < 8; ++e) acc[e] = 0.f;
#pragma unroll
            for (int p = 0; p < 3; ++p) { const float wp = wgt[p] * iw;
#pragma unroll
                for (int e2 = 0; e2 < 4; ++e2) { acc[2 * e2] += wp * blo(ov[k][p][e2]); acc[2 * e2 + 1] += wp * bhi(ov[k][p][e2]); } }
            v4u o; o.x = pk2(acc[0], acc[1]); o.y = pk2(acc[2], acc[3]); o.z = pk2(acc[4], acc[5]); o.w = pk2(acc[6], acc[7]);
            *(v4u*)(MIX + (size_t)tok * 1024 + hh * 64 + pc * 8) = o; }
    }
    }
    if (MODE == 2) {
#pragma unroll 2
    for (int idx = gtid; idx < (MT / 8) * 64; idx += nthr) {
        const int tg = idx >> 6, cb = idx & 63, g = cb >> 4, wdw = 2 << g, tok0 = tg * 8, t0 = tok0 & (SEQ - 1);
        const bf16* up = Z + (size_t)tok0 * NZ + 1536 + cb * 8;
        float sum[8];
#pragma unroll
        for (int e = 0; e < 8; ++e) sum[e] = 0.f;
        const int back = (wdw - 1) < t0 ? (wdw - 1) : t0;
        for (int i = 1; i <= back; ++i) { const v4u v = *(const v4u*)(up - (size_t)i * NZ);
#pragma unroll
            for (int e2 = 0; e2 < 4; ++e2) { sum[2 * e2] += blo(v[e2]); sum[2 * e2 + 1] += bhi(v[e2]); } }
        v4u cur[8];
#pragma unroll
        for (int jj = 0; jj < 8; ++jj) cur[jj] = *(const v4u*)(up + (size_t)jj * NZ);
#pragma unroll
        for (int jj = 0; jj < 8; ++jj) {
#pragma unroll
            for (int e2 = 0; e2 < 4; ++e2) { sum[2 * e2] += blo(cur[jj][e2]); sum[2 * e2 + 1] += bhi(cur[jj][e2]); }
            const int t = t0 + jj; const int cnt = (t + 1) < wdw ? (t + 1) : wdw; const float ic = 1.0f / (float)cnt;
            v4u o; o.x = pk2(sum[0] * ic - blo(cur[jj].x), sum[1] * ic - bhi(cur[jj].x)); o.y = pk2(sum[2] * ic - blo(cur[jj].y), sum[3] * ic - bhi(cur[jj].y));
            o.z = pk2(sum[4] * ic - blo(cur[jj].z), sum[5] * ic - bhi(cur[jj].z)); o.w = pk2(sum[6] * ic - blo(cur[jj].w), sum[7] * ic - bhi(cur[jj].w));
            *(v4u*)(MIX + (size_t)(tok0 + jj) * 1024 + 512 + cb * 8) = o;
            const int tout = t + 1 - wdw;
            if (jj < 7 && tout >= 0) { const v4u v = *(const v4u*)(up + ((ptrdiff_t)(jj + 1) - wdw) * NZ);
#pragma unroll
                for (int e2 = 0; e2 < 4; ++e2) { sum[2 * e2] -= blo(v[e2]); sum[2 * e2 + 1] -= bhi(v[e2]); } }
        }
    }
    }
}

__device__ __forceinline__ void conv_fixup_panel(const float* halo, const float* cw, const float* cb, bf16* act, int pm, int tid) {
    if ((pm & 15) == 0) return;
    for (int idx = tid; idx < 2 * (FF / 4); idx += NWAVES * 64) {
        const int rs = idx / (FF / 4), gc = (idx % (FF / 4)) * 4, pn = gc >> 7, j = gc & 127;
        f32x4 y[2];
#pragma unroll
        for (int bj = 0; bj < 2; ++bj) { const int c = bj * FF + gc;
#define HAL(pm_, rsel_) (*(const f32x4*)(halo + ((size_t)((pm_) * 4 + (rsel_)) * 22 + pn) * 256 + bj * 128 + j))
            f32x4 u0, um1, um2;
            if (rs == 0) { u0 = HAL(pm, 0); um1 = HAL(pm - 1, 3); um2 = HAL(pm - 1, 2); } else { u0 = HAL(pm, 1); um1 = HAL(pm, 0); um2 = HAL(pm - 1, 3); }
#undef HAL
            y[bj] = *(const f32x4*)(cw + c) * um2 + *(const f32x4*)(cw + NUP + c) * um1 + *(const f32x4*)(cw + 2 * NUP + c) * u0 + *(const f32x4*)(cb + c); }
        f32x4 a;
#pragma unroll
        for (int e2 = 0; e2 < 4; ++e2) a[e2] = y[0][e2] * pg8::sigmoidf_(y[0][e2]) * y[1][e2];
        v2u w; w.x = pk2(a[0], a[1]); w.y = pk2(a[2], a[3]);
        *(v2u*)(act + (size_t)(pm * 256 + rs) * FF + gc) = w;
    }
}

#define XB_TMO      128
#define XB_XCNT(j)  (256  + 64 * (j))
#define XB_XSUB(j)  (1280 + 64 * (j))
#define XB_XGEN(j)  (2304 + 64 * (j))
#define XB_TOP      3328
#define XB_TOPGEN   3392
#define XCD_BAR_WORDS 3456
#define XB_SPIN_CAP (1u << 18)

__device__ __forceinline__ unsigned xb_ld(unsigned* p)              { return __hip_atomic_load(p, __ATOMIC_RELAXED, __HIP_MEMORY_SCOPE_AGENT); }
__device__ __forceinline__ unsigned xb_add(unsigned* p, unsigned v) { return __hip_atomic_fetch_add(p, v, __ATOMIC_RELAXED, __HIP_MEMORY_SCOPE_AGENT); }
__device__ __forceinline__ unsigned xb_xcc_id() { return (unsigned)__builtin_amdgcn_s_getreg((3 << 11) | 20) & 0xFu; }
#define XB_SPIN(cond, bar) do { unsigned _sp = 0; while (cond) { __builtin_amdgcn_s_sleep(1); \
    if ((++_sp & 255u) == 0u) { if (xb_ld(&(bar)[XB_TMO])) break; if (_sp > XB_SPIN_CAP) { atomicAdd(&(bar)[XB_TMO], 1u); break; } } } } while (0)

struct XcdBarrier {
    unsigned* bar; unsigned x;
    volatile LAS unsigned* st;
};

__device__ __forceinline__ XcdBarrier xcd_barrier_post(unsigned* bar, volatile LAS unsigned* st) {
    XcdBarrier b; b.bar = bar; b.x = xb_xcc_id(); b.st = st;
    if (threadIdx.x == 0) (void)xb_add(&bar[XB_XCNT(b.x)], 1u);
    return b;
}
__device__ __forceinline__ void xcd_barrier_complete(unsigned* bar, unsigned x, unsigned& nloc, unsigned& nx) {
    const unsigned G = gridDim.x * gridDim.y * gridDim.z;
    unsigned sum, cnt, mine, sp = 0u;
    for (;;) {
        sum = 0u; cnt = 0u; mine = 0u;
#pragma unroll
        for (unsigned j = 0; j < 16; ++j) { const unsigned c = xb_ld(&bar[XB_XCNT(j)]); sum += c; cnt += (c > 0u) ? 1u : 0u; mine = (j == x) ? c : mine; }
        if (sum == G) break;
        __builtin_amdgcn_s_sleep(1);
        if ((++sp & 255u) == 0u) { if (xb_ld(&bar[XB_TMO])) break; if (sp > XB_SPIN_CAP) { atomicAdd(&bar[XB_TMO], 1u); break; } }
    }
    nloc = mine > 0u ? mine : 1u; nx = cnt > 0u ? cnt : 1u;
}

__device__ __forceinline__ void xcd_barrier(const XcdBarrier& b) {
    asm volatile("s_waitcnt vmcnt(0)" ::: "memory");
    __syncthreads();
    if (threadIdx.x == 0) {
        unsigned* bar = b.bar;
        __builtin_amdgcn_s_waitcnt(0);
        unsigned nloc = b.st[0], nx = b.st[1];
        if (nloc == 0u) { xcd_barrier_complete(bar, b.x, nloc, nx); b.st[0] = nloc; b.st[1] = nx; }
        const unsigned old = xb_add(&bar[XB_XSUB(b.x)], 1u);
        const unsigned gen = old / nloc;
        if (old + 1u == (gen + 1u) * nloc) {
            __builtin_amdgcn_fence(__ATOMIC_RELEASE, "agent");
            asm volatile("s_waitcnt vmcnt(0)" ::: "memory");
            const unsigned og = xb_add(&bar[XB_TOP], 1u);
            const unsigned tg = og / nx;
            if (og + 1u == (tg + 1u) * nx) xb_add(&bar[XB_TOPGEN], 1u);
            else XB_SPIN(xb_ld(&bar[XB_TOPGEN]) == tg, bar);
            __builtin_amdgcn_fence(__ATOMIC_ACQUIRE, "agent");
            xb_add(&bar[XB_XGEN(b.x)], 1u);
            asm volatile("s_waitcnt vmcnt(0)" ::: "memory");
        } else {
            XB_SPIN(xb_ld(&bar[XB_XGEN(b.x)]) == gen, bar);
            __builtin_amdgcn_fence(__ATOMIC_ACQUIRE, "agent");
            asm volatile("s_waitcnt vmcnt(0)" ::: "memory");
        }
    }
    __syncthreads();
}


__device__ __forceinline__ void atomic_grid_barrier(unsigned* ctr, unsigned nblocks) {
    asm volatile("s_waitcnt vmcnt(0)" ::: "memory");
    __syncthreads();
    if (threadIdx.x == 0) {
        __builtin_amdgcn_fence(__ATOMIC_RELEASE, "agent");
        asm volatile("s_waitcnt vmcnt(0)" ::: "memory");
        __hip_atomic_fetch_add(ctr, 1u, __ATOMIC_RELAXED, __HIP_MEMORY_SCOPE_AGENT);
        while (__hip_atomic_load(ctr, __ATOMIC_RELAXED, __HIP_MEMORY_SCOPE_AGENT) < nblocks) __builtin_amdgcn_s_sleep(2);
        __builtin_amdgcn_fence(__ATOMIC_ACQUIRE, "agent");
        asm volatile("s_waitcnt vmcnt(0)" ::: "memory");
    }
    __syncthreads();
}


constexpr int NPH = 10;
#ifndef REPS
#define REPS {1,1,1,1,1,1,1,1,1,1}
#endif
__device__ constexpr int kReps[10] = REPS;
__global__ void __launch_bounds__(NWAVES * 64, 2) hybrid_fwd(Args args) {
    extern __shared__ __attribute__((aligned(16))) unsigned char lds_raw[];
    LAS unsigned char* lds = (LAS unsigned char*)lds_raw;
    cg::grid_group grid = cg::this_grid();
    if (threadIdx.x < 2) ((LAS unsigned*)(lds + 131072 + 8192))[threadIdx.x] = 0u;
    __syncthreads();
    const int tid = threadIdx.x, lane = tid & 63, wave = __builtin_amdgcn_readfirstlane(tid >> 6);
    const int G = gridDim.x, bx = blockIdx.x;
    const int gw = bx * NWAVES + wave, NGW = G * NWAVES, gws = wave * G + bx;
    const int gtid = bx * (NWAVES * 64) + tid, nthr = G * NWAVES * 64;
    unsigned char* ws = karg_ws();
    bf16* XN = (bf16*)(ws + WS_XN); bf16* PB = (bf16*)(ws + WS_PB); bf16* EB = (bf16*)(ws + WS_E); bf16* Z = (bf16*)(ws + WS_Z);
    bf16* OP = (bf16*)(ws + WS_OP); float* ML = (float*)(ws + WS_ML); bf16* MIX = (bf16*)(ws + WS_MIX); float* HALO = (float*)(ws + WS_HALO);
    float* SS1 = (float*)(ws + WS_SS1); float* SS2 = (float*)(ws + WS_SS2); bf16* ACT = (bf16*)(ws + WS_ACT);
    const int lo = karg_i32(144), hi = karg_i32(148);
    XcdBarrier xbar = xcd_barrier_post((unsigned*)ws + 1024, (volatile LAS unsigned*)(lds + 131072 + 8192));
    if (lo > hi) grid.sync();
#ifndef PHMASK
#define PHMASK 0x3ff
#endif
#define IN(k) (((PHMASK >> (k)) & 1) && lo <= (k) && (k) < hi)
#define SEAM(k) do { if (IN(k) && IN((k) + 1)) xcd_barrier(xbar); } while (0)

    if (IN(0)) for (int rep_ = 0; rep_ < kReps[0]; ++rep_) { p0_prologue(ws, lds, gw, NGW, gws, lane, wave); }
    SEAM(0);
    if (IN(1)) for (int rep_ = 0; rep_ < kReps[1]; ++rep_) {
        { pg8::Gemm g{XN, (const bf16*)(ws + WS_WIN), MT, NZ, DM}; pg8::StaticOrder S; S.init(MT, NZ, G, bx); pg8::EpiStoreBf16T<true> E{Z, NZ, (const float*)(ws + WS_RI)};
          pg8::gemm_phase<pg8::EpiStoreBf16T<true>, pg8::StaticOrder, true, true>(lds, g, S, E); }
    }
    SEAM(1);
    if (IN(2)) for (int rep_ = 0; rep_ < kReps[2]; ++rep_) {
        v4u kr[6], vr[6]; bf16x8 qn[4]; int it = bx;
        AttnIt An = attn_decode(it); attn_prefetch(Z, An, tid, kr, vr, qn);
        merge_pool<2>(Z, OP, ML, MIX, gtid, nthr);
#pragma unroll 1
        for (; it < 64 * 48; it += G) {
            const AttnIt Ac = An; bf16x8 qc[4];
#pragma unroll
            for (int s = 0; s < 4; ++s) qc[s] = qn[s];
            attn_stage(lds, tid, kr, vr);
            __syncthreads();
            if (it + G < 64 * 48) { An = attn_decode(it + G); attn_prefetch(Z, An, tid, kr, vr, qn); }
            attn_compute(lds, OP, ML, Ac, tid, qc);
            __syncthreads();
        }
    }
    SEAM(2);
    if (IN(3)) for (int rep_ = 0; rep_ < kReps[3]; ++rep_) { merge_pool<1>(Z, OP, ML, MIX, gtid, nthr); }
    SEAM(3);
    if (IN(4)) for (int rep_ = 0; rep_ < kReps[4]; ++rep_) {
        pg8::Gemm g{MIX, (const bf16*)(ws + WS_WO), MT, DM, DM}; pg8::StaticOrder S; S.init(MT, DM, G, bx); pg8::EpiRes<false> E{nullptr, XN, SS1};
        pg8::gemm_phase<pg8::EpiRes<false>, pg8::StaticOrder, true, true>(lds, g, S, E);
    }
    SEAM(4);
    if (IN(5)) for (int rep_ = 0; rep_ < kReps[5]; ++rep_) {
        pg8::Gemm g{XN, (const bf16*)(ws + WS_WUP), MT, NUP, DM}; pg8::StaticOrder S; S.init(MT, NUP, G, bx); pg8::EpiConv E{SS1, karg_in(9), karg_in(10), ACT, HALO};
        pg8::gemm_phase<pg8::EpiConv, pg8::StaticOrder, true, true>(lds, g, S, E);
    }
    SEAM(5);
    if (IN(7)) {
        { const int t7 = (int)__builtin_amdgcn_mbcnt_hi(~0u, __builtin_amdgcn_mbcnt_lo(~0u, 0u)) + 64 * __builtin_amdgcn_readfirstlane((int)threadIdx.x >> 6);
          pg8::StaticOrder S0; S0.init(MT, DM, G, bx); pg8::Unit u0; const float* cwp = karg_in(9); const float* cbp = karg_in(10);
          for (int i = 0; S0.next(i, u0); ++i) conv_fixup_panel(HALO, cwp, cbp, ACT, u0.pm, t7);
          asm volatile("s_waitcnt vmcnt(0)" ::: "memory"); __syncthreads();
          if (threadIdx.x == 0) { __builtin_amdgcn_fence(__ATOMIC_ACQUIRE, "agent"); asm volatile("s_waitcnt vmcnt(0)" ::: "memory"); }
          __syncthreads(); }
#ifdef PROBE_P7
        { pg8::Gemm g{ACT, (const bf16*)(ws + WS_WDN), MT, DM, FF}; pg8::StaticOrder S; S.init(MT, DM, G, bx); pg8::EpiStoreBf16 E{MIX, DM, nullptr}; pg8::gemm_phase<pg8::EpiStoreBf16, pg8::StaticOrder, true, true>(lds, g, S, E); }
#endif
        pg8::Gemm g{ACT, (const bf16*)(ws + WS_WDN), MT, DM, FF}; pg8::StaticOrder S; S.init(MT, DM, G, bx); pg8::EpiRes<false> E{nullptr, XN, SS2};
        pg8::gemm_phase<pg8::EpiRes<false>, pg8::StaticOrder, true, true>(lds, g, S, E);
        { pg8::Gemm g{PB, (const bf16*)(ws + WS_WPLE), MT, DM, PLE}; pg8::StaticOrder S; S.init(MT, DM, G, bx); pg8::EpiStoreBf16 E{EB, DM, nullptr};
          pg8::gemm_phase<pg8::EpiStoreBf16, pg8::StaticOrder, true, true>(lds, g, S, E); }
    }
    SEAM(7);
    if (IN(8)) for (int rep_ = 0; rep_ < kReps[8]; ++rep_) {
        pg8::Gemm g{XN, (const bf16*)(ws + WS_WG), MT, DM, DM}; pg8::StaticOrder S; S.init(MT, DM, G, bx); pg8::EpiGate E{SS2, EB, XN, MIX};
        pg8::gemm_phase<pg8::EpiGate, pg8::StaticOrder, true, true>(lds, g, S, E);
    }
    SEAM(8);
    if (IN(9)) for (int rep_ = 0; rep_ < kReps[9]; ++rep_) {
        const int lane9 = (int)__builtin_amdgcn_mbcnt_hi(~0u, __builtin_amdgcn_mbcnt_lo(~0u, 0u)); const int gw9 = bx * NWAVES + __builtin_amdgcn_readfirstlane((int)threadIdx.x >> 6);
        const float* lnf = karg_in(15); float* outp = karg_out(); f32x4 g[4];
#pragma unroll
        for (int j = 0; j < 4; ++j) g[j] = ((const f32x4*)lnf)[lane9 + 64 * j];
        for (int m = gw9; m < MT; m += 2 * NGW) {
            const int m2 = (m + NGW) < MT ? (m + NGW) : (MT - 1);
            const v2u* hr = (const v2u*)(MIX + (size_t)m * DM) + lane9; const v2u* hr2 = (const v2u*)(MIX + (size_t)m2 * DM) + lane9; v2u a[4], b[4];
#pragma unroll
            for (int j = 0; j < 4; ++j) { a[j] = __builtin_nontemporal_load(hr + 64 * j); b[j] = __builtin_nontemporal_load(hr2 + 64 * j); }
            f32x4 v[4], u[4]; float s = 0.f, s2 = 0.f;
#pragma unroll
            for (int j = 0; j < 4; ++j) { v[j] = (f32x4){blo(a[j].x), bhi(a[j].x), blo(a[j].y), bhi(a[j].y)}; u[j] = (f32x4){blo(b[j].x), bhi(b[j].x), blo(b[j].y), bhi(b[j].y)};
                s += (v[j].x * v[j].x + v[j].y * v[j].y) + (v[j].z * v[j].z + v[j].w * v[j].w); s2 += (u[j].x * u[j].x + u[j].y * u[j].y) + (u[j].z * u[j].z + u[j].w * u[j].w); }
            const float inv = 1.0f / sqrtf(wave_sum(s) * (1.0f / DM) + 1e-6f), inv2 = 1.0f / sqrtf(wave_sum(s2) * (1.0f / DM) + 1e-6f);
            f32x4* xr = (f32x4*)(outp + (size_t)m * DM) + lane9; f32x4* xr2 = (f32x4*)(outp + (size_t)m2 * DM) + lane9;
#pragma unroll
            for (int j = 0; j < 4; ++j) { __builtin_nontemporal_store(v[j] * inv * g[j], xr + 64 * j); __builtin_nontemporal_store(u[j] * inv2 * g[j], xr2 + 64 * j); }
        }
    }
#undef IN
#undef SEAM
}

#ifndef N_LAUNCHES
#define N_LAUNCHES 1
#endif
extern "C" void kernel_launch(void* const* d_in, const int* in_sizes, int n_in, void* d_out, int out_size, void* d_ws, size_t ws_size, hipStream_t stream) {
    static int grid = 0;
    if (grid == 0) {
        if (n_in != 16 || out_size != MT * DM || ws_size < WS_END) { fprintf(stderr, "kernel_launch: unexpected shapes (n_in %d out %d ws %zu)\n", n_in, out_size, ws_size); grid = -1; return; }
        int dev = 0, cus = 0, per_cu = 0;
        hipGetDevice(&dev); hipDeviceGetAttribute(&cus, hipDeviceAttributeMultiprocessorCount, dev);
        if (hipFuncSetAttribute((const void*)hybrid_fwd, hipFuncAttributeMaxDynamicSharedMemorySize, LDS_BYTES) != hipSuccess) { fprintf(stderr, "kernel_launch: hipFuncSetAttribute failed\n"); grid = -1; return; }
        if (hipOccupancyMaxActiveBlocksPerMultiprocessor(&per_cu, (const void*)hybrid_fwd, NWAVES * 64, LDS_BYTES) != hipSuccess || per_cu < 1) { fprintf(stderr, "kernel_launch: occupancy query says %d\n", per_cu); per_cu = 1; }
        (void)hipGetLastError();
        grid = cus * (per_cu > 1 ? 1 : per_cu);
    }
    if (grid < 0) return;
    if (hipMemsetAsync(d_ws, 0, 32768, stream) != hipSuccess) { fprintf(stderr, "kernel_launch: memset failed\n"); return; }
    Args a{};
    for (int i = 0; i < 16; ++i) a.in[i] = (const float*)d_in[i];
    a.out = (float*)d_out; a.ws = (unsigned char*)d_ws;
    if (N_LAUNCHES == 1) {
        a.ph_lo = 0; a.ph_hi = NPH;
        void* kargs[] = {&a};
        hipError_t e = hipLaunchCooperativeKernel((const void*)hybrid_fwd, dim3(grid), dim3(NWAVES * 64), kargs, LDS_BYTES, stream);
        if (e != hipSuccess) fprintf(stderr, "cooperative launch failed: %s (grid %d)\n", hipGetErrorString(e), grid);
    } else {
        for (int k = 0; k < NPH; ++k) { a.ph_lo = k; a.ph_hi = k + 1; hipLaunchKernelGGL(hybrid_fwd, dim3(grid), dim3(NWAVES * 64), LDS_BYTES, stream, a); }
    }
}
```

```cpp
#include <hip/hip_runtime.h>
#include <hip/hip_cooperative_groups.h>
#include <cstdio>
#include <cstdint>
namespace cg = cooperative_groups;
namespace pg8 {
#define PG8_LAS __attribute__((address_space(3)))
typedef unsigned short bf16_t;
typedef short bf16x8 __attribute__((ext_vector_type(8)));
typedef float f32x4 __attribute__((ext_vector_type(4)));
typedef unsigned u32x4 __attribute__((ext_vector_type(4)));
constexpr int BM = 256, BK = 64, HALF = 128, HTB = HALF * BK * 2  , STAGE_BYTES = 8 * HTB, NXCD = 8, WGM = 8;

__host__ __device__ __forceinline__ int lds_byte(int r, int c) { const int st = (r >> 4) * 2 + (c >> 5), rr = r & 15, cc = c & 31, ob = rr * 64 + cc * 2; return st * 1024 + (ob ^ (((ob >> 9) & 1) << 5)); }
__host__ __device__ __forceinline__ void stage_rc(int b, int& R, int& C) { const int st = b / 1024, sb = b % 1024, swz = sb ^ (((sb >> 9) & 1) << 5); R = (st >> 1) * 16 + swz / 64; C = (st & 1) * 32 + (swz % 64) / 2; }
__host__ __device__ __forceinline__ int perm32(int rho) { const int n = rho >> 4, i = rho & 15; return 8 * (i >> 2) + 4 * n + (i & 3); }

struct Unit { int pm, pn; };
struct Gemm { const bf16_t* A; const bf16_t* Bt; int M, N, K; };

struct StaticOrder {
    int nM, nN, nwg, G, c;
    __host__ __device__ void init(int M, int N, int G_, int c_) { nM = M / BM; nN = N / BM; nwg = nM * nN; G = G_; c = c_; }
    __host__ __device__ bool next(int i, Unit& u) const {
        const long L = (long)i * G + c; if (L >= nwg) return false;
        int wgid = (int)L; { const int q = nwg / NXCD, r = nwg % NXCD, xcd = wgid % NXCD, off = wgid / NXCD; wgid = (xcd < r ? xcd * (q + 1) : r * (q + 1) + (xcd - r) * q) + off; }
        const int nig = WGM * nN, gid = wgid / nig, fm = gid * WGM, gsz = (nM - fm) < WGM ? (nM - fm) : WGM;
        u.pm = fm + ((wgid % nig) % gsz); u.pn = (wgid % nig) / gsz; return true;
    }
    __device__ __forceinline__ void a_ready(const Unit&) const {}
    __device__ __forceinline__ void done(const Unit&) const {}
};

__device__ __forceinline__ unsigned cvt_pk_bf16(float lo, float hi) { unsigned r; asm volatile("v_cvt_pk_bf16_f32 %0, %1, %2" : "=v"(r) : "v"(lo), "v"(hi)); return r; }
typedef unsigned u32x2 __attribute__((ext_vector_type(2)));
typedef float f32x2 __attribute__((ext_vector_type(2)));
__device__ __forceinline__ float bf_lo(unsigned w) { return __uint_as_float(w << 16); }
__device__ __forceinline__ float bf_hi(unsigned w) { return __uint_as_float(w & 0xffff0000u); }

template <bool ROWSCALE> struct EpiStoreBf16T {
    static constexpr bool PERM = true, AFTER_DRAIN = false, LINE = true;
    bf16_t* O; int ldc; const float* rs;
    __device__ __forceinline__ void operator()(f32x4 (&acc)[2][2][4][2], const Unit& u, int wr, int wc, int fr, int fq, PG8_LAS unsigned char*) const {
        const int row0 = u.pm * BM + wr * 64 + fr, col0 = u.pn * BM + wc * 64 + 8 * fq;
        float sc[2][4];
        if (ROWSCALE) {
#pragma unroll
            for (int ai = 0; ai < 2; ++ai)
#pragma unroll
                for (int m = 0; m < 4; ++m) sc[ai][m] = rs[row0 + ai * HALF + m * 16];
        }
#pragma unroll
        for (int ai = 0; ai < 2; ++ai)
#pragma unroll
            for (int m = 0; m < 4; ++m) { bf16_t* rowp = O + (size_t)(row0 + ai * HALF + m * 16) * ldc + col0;
#pragma unroll
                for (int bj = 0; bj < 2; ++bj) { f32x4 v0 = acc[ai][bj][m][0], v1 = acc[ai][bj][m][1];
                    if (ROWSCALE) { v0 = v0 * sc[ai][m]; v1 = v1 * sc[ai][m]; }
                    u32x4 w; w.x = cvt_pk_bf16(v0[0], v0[1]); w.y = cvt_pk_bf16(v0[2], v0[3]); w.z = cvt_pk_bf16(v1[0], v1[1]); w.w = cvt_pk_bf16(v1[2], v1[3]);
                    *(u32x4*)(rowp + bj * 32) = w; } }
    }
};
typedef EpiStoreBf16T<false> EpiStoreBf16;

template <bool BASE_F32> struct EpiRes {
    static constexpr bool PERM = true, AFTER_DRAIN = false, LINE = true;
    const float* base; bf16_t* hb; float* ss;
    __device__ __forceinline__ void operator()(f32x4 (&acc)[2][2][4][2], const Unit& u, int wr, int wc, int fr, int fq, PG8_LAS unsigned char*) const {
        const int col0 = u.pn * BM + wc * 64 + 8 * fq;
#pragma unroll
        for (int ai = 0; ai < 2; ++ai) {
            int r0 = u.pm * BM + ai * HALF + wr * 64 + fr; asm volatile("" : "+v"(r0));
            const size_t off0 = (size_t)r0 * 1024 + col0;
            f32x4 bq[4][2][2]; u32x4 bh[4][2];
#pragma unroll
            for (int m = 0; m < 4; ++m)
#pragma unroll
                for (int bj = 0; bj < 2; ++bj) { const size_t o = off0 + (size_t)m * 16 * 1024 + bj * 32;
                    if (BASE_F32) { bq[m][bj][0] = *(const f32x4*)(base + o); bq[m][bj][1] = *(const f32x4*)(base + o + 4); } else bh[m][bj] = *(const u32x4*)(hb + o); }
#pragma unroll
            for (int m = 0; m < 4; ++m) { float s = 0.f;
#pragma unroll
                for (int bj = 0; bj < 2; ++bj) { const size_t o = off0 + (size_t)m * 16 * 1024 + bj * 32; f32x4 b0, b1;
                    if (BASE_F32) { b0 = bq[m][bj][0]; b1 = bq[m][bj][1]; }
                    else { const u32x4 bw = bh[m][bj]; b0 = (f32x4){bf_lo(bw.x), bf_hi(bw.x), bf_lo(bw.y), bf_hi(bw.y)}; b1 = (f32x4){bf_lo(bw.z), bf_hi(bw.z), bf_lo(bw.w), bf_hi(bw.w)}; }
                    const f32x4 o0 = b0 + acc[ai][bj][m][0], o1 = b1 + acc[ai][bj][m][1];
                    u32x4 w; w.x = cvt_pk_bf16(o0[0], o0[1]); w.y = cvt_pk_bf16(o0[2], o0[3]); w.z = cvt_pk_bf16(o1[0], o1[1]); w.w = cvt_pk_bf16(o1[2], o1[3]);
                    *(u32x4*)(hb + o) = w;
                    s += ((o0[0] * o0[0] + o0[1] * o0[1]) + (o0[2] * o0[2] + o0[3] * o0[3])) + ((o1[0] * o1[0] + o1[1] * o1[1]) + (o1[2] * o1[2] + o1[3] * o1[3])); }
                s += __shfl_xor(s, 16); { const auto r2 = __builtin_amdgcn_permlane32_swap(__float_as_uint(s), __float_as_uint(s), false, false); s = __uint_as_float(r2[0]) + __uint_as_float(r2[1]); }
                if (fq == 0) (void)__hip_atomic_fetch_add(ss + r0 + m * 16, s, __ATOMIC_RELAXED, __HIP_MEMORY_SCOPE_AGENT); }
            asm volatile("" ::: "memory"); __builtin_amdgcn_sched_barrier(0);
        }
    }
};

__device__ __forceinline__ float inv_from_ss(float t) { return __builtin_amdgcn_rsqf(t * (1.0f / 1024.0f) + 1e-6f); }
__device__ __forceinline__ float sigmoidf_(float x) { return __builtin_amdgcn_rcpf(1.0f + __builtin_amdgcn_exp2f(-1.4426950408889634f * x)); }

struct EpiGate {
    static constexpr bool PERM = true, AFTER_DRAIN = false, LINE = true;
    const float* ss_in; const bf16_t* E; const bf16_t* hb; bf16_t* out;
    __device__ __forceinline__ void operator()(f32x4 (&acc)[2][2][4][2], const Unit& u, int wr, int wc, int fr, int fq, PG8_LAS unsigned char*) const {
        const int col0 = u.pn * BM + wc * 64 + 8 * fq;
#pragma unroll
        for (int ai = 0; ai < 2; ++ai) {
            int r0 = u.pm * BM + ai * HALF + wr * 64 + fr; asm volatile("" : "+v"(r0));
            const size_t off0 = (size_t)r0 * 1024 + col0;
            u32x4 hv[4][2], ev[4][2]; float sq[4];
#pragma unroll
            for (int m = 0; m < 4; ++m) { sq[m] = ss_in[r0 + m * 16];
#pragma unroll
                for (int bj = 0; bj < 2; ++bj) { const size_t o = off0 + (size_t)m * 16 * 1024 + bj * 32; hv[m][bj] = *(const u32x4*)(hb + o); ev[m][bj] = *(const u32x4*)(E + o); } }
#pragma unroll
            for (int m = 0; m < 4; ++m) { const float inv = inv_from_ss(sq[m]);
#pragma unroll
                for (int bj = 0; bj < 2; ++bj) { const size_t o = off0 + (size_t)m * 16 * 1024 + bj * 32; const u32x4 h2 = hv[m][bj], e2 = ev[m][bj];
                    const f32x4 a0 = acc[ai][bj][m][0] * inv, a1 = acc[ai][bj][m][1] * inv; float ov[8];
                    const unsigned hw[4] = {h2.x, h2.y, h2.z, h2.w}, ew[4] = {e2.x, e2.y, e2.z, e2.w};
#pragma unroll
                    for (int k = 0; k < 4; ++k) { const f32x2 av = (k < 2) ? (f32x2){a0[2 * k], a0[2 * k + 1]} : (f32x2){a1[2 * k - 4], a1[2 * k - 3]};
                        const f32x2 t = av * (-1.4426950408889634f); f32x2 d; d.x = __builtin_amdgcn_exp2f(t.x); d.y = __builtin_amdgcn_exp2f(t.y); d = d + 1.0f;
                        f32x2 sg; sg.x = __builtin_amdgcn_rcpf(d.x); sg.y = __builtin_amdgcn_rcpf(d.y);
                        const f32x2 hh = (f32x2){bf_lo(hw[k]), bf_hi(hw[k])}, ee = (f32x2){bf_lo(ew[k]), bf_hi(ew[k])}; const f32x2 r = hh + sg * ee; ov[2 * k] = r.x; ov[2 * k + 1] = r.y; }
                    u32x4 w; w.x = cvt_pk_bf16(ov[0], ov[1]); w.y = cvt_pk_bf16(ov[2], ov[3]); w.z = cvt_pk_bf16(ov[4], ov[5]); w.w = cvt_pk_bf16(ov[6], ov[7]);
                    *(u32x4*)(out + o) = w; } }
            asm volatile("" ::: "memory"); __builtin_amdgcn_sched_barrier(0);
        }
    }
};

#define DPPR(src_, ctrl_) __uint_as_float((unsigned)__builtin_amdgcn_update_dpp(0, (int)__float_as_uint(src_), ctrl_, 0xf, 0xf, true))
#define DPPF(old_, src_, ctrl_) __uint_as_float((unsigned)__builtin_amdgcn_update_dpp((int)__float_as_uint(old_), (int)__float_as_uint(src_), ctrl_, 0xf, 0xf, false))
struct EpiConv {
    static constexpr bool PERM = true, AFTER_DRAIN = false;
    const float* ss_in; const float* cw; const float* cb; bf16_t* act; float* halo;
    __device__ __forceinline__ void operator()(f32x4 (&acc)[2][2][4][2], const Unit& u, int wr, int wc, int fr_, int fq_, PG8_LAS unsigned char* lds) const {
        int fr = fr_, fq = fq_; asm volatile("" : "+v"(fr), "+v"(fq));
        PG8_LAS float* X = (PG8_LAS float*)(lds + 131072);
        f32x4 cA[2][4];
#pragma unroll
        for (int bj = 0; bj < 2; ++bj) { const int c = bj * 2816 + u.pn * 128 + wc * 32 + 8 * fq; cA[bj][0] = *(const f32x4*)(cw + c); cA[bj][1] = *(const f32x4*)(cw + 5632 + c); cA[bj][2] = *(const f32x4*)(cw + 2 * 5632 + c); cA[bj][3] = *(const f32x4*)(cb + c); }
        { float sq[2][4];
#pragma unroll
          for (int ai = 0; ai < 2; ++ai)
#pragma unroll
              for (int m = 0; m < 4; ++m) sq[ai][m] = ss_in[u.pm * BM + ai * HALF + wr * 64 + m * 16 + fr];
#pragma unroll
          for (int ai = 0; ai < 2; ++ai)
#pragma unroll
              for (int m = 0; m < 4; ++m) { const float inv = inv_from_ss(sq[ai][m]);
#pragma unroll
                  for (int bj = 0; bj < 2; ++bj)
#pragma unroll
                      for (int n = 0; n < 2; ++n) acc[ai][bj][m][n] = acc[ai][bj][m][n] * inv; }
          asm volatile("" ::: "memory"); __builtin_amdgcn_sched_barrier(0); }
        if (fr >= 14) {
#pragma unroll
            for (int ai = 0; ai < 2; ++ai) { const int xb = (((((wr * 2 + ai) * 4 + wc) * 2 + (fr - 14)) * 4) + fq) * 16;
#pragma unroll
                for (int bj = 0; bj < 2; ++bj)
#pragma unroll
                    for (int n = 0; n < 2; ++n) *(PG8_LAS f32x4*)(X + xb + bj * 8 + n * 4) = acc[ai][bj][3][n]; }
            if (wr == 1) { float* hp = halo + ((size_t)(u.pm * 4 + 2 + (fr - 14)) * 22 + u.pn) * 256 + wc * 32 + 8 * fq;
#pragma unroll
                for (int bj = 0; bj < 2; ++bj)
#pragma unroll
                    for (int n = 0; n < 2; ++n) *(f32x4*)(hp + bj * 128 + 4 * n) = acc[1][bj][3][n]; }
        }
        if (fr < 2 && wr == 0) { float* hp = halo + ((size_t)(u.pm * 4 + fr) * 22 + u.pn) * 256 + wc * 32 + 8 * fq;
#pragma unroll
            for (int bj = 0; bj < 2; ++bj)
#pragma unroll
                for (int n = 0; n < 2; ++n) *(f32x4*)(hp + bj * 128 + 4 * n) = acc[0][bj][0][n]; }
        asm volatile("s_waitcnt lgkmcnt(0)" ::: "memory"); __builtin_amdgcn_s_barrier(); asm volatile("" ::: "memory");
        const int pwr = wr ^ 1;
        u32x2 stash[2][4];
        auto grp = [&](const int n, const int ai, const f32x4 (&C)[2][4]) __attribute__((always_inline)) {
            const int gc = u.pn * 128 + wc * 32 + 8 * fq + 4 * n;
#pragma unroll
            for (int m = 0; m < 4; ++m) {
                int r = u.pm * BM + ai * HALF + wr * 64 + m * 16 + fr; asm volatile("" : "+v"(r));
                f32x4 y[2];
#pragma unroll
                for (int bj = 0; bj < 2; ++bj) {
                    const f32x4 U = acc[ai][bj][m][n]; f32x4 t1, t2;
                    if (m == 0) {
                        if (ai == 0 && wr == 0) { t1 = (f32x4){0.f, 0.f, 0.f, 0.f}; t2 = t1; }
                        else { const int pai = (wr == 1) ? ai : 0; const int xb = ((((pwr * 2 + pai) * 4 + wc) * 2) * 4 + fq) * 16 + bj * 8 + n * 4;
                            t1 = *(const PG8_LAS f32x4*)(X + xb + 64); t2 = *(const PG8_LAS f32x4*)(X + xb + (fr == 0 ? 0 : 64)); }
                    } else { const f32x4 Up = acc[ai][bj][m - 1][n];
#pragma unroll
                        for (int e = 0; e < 4; ++e) { t1[e] = DPPR(Up[e], 0x121); t2[e] = DPPR(Up[e], 0x122); } }
                    f32x4 P1, P2;
#pragma unroll
                    for (int e = 0; e < 4; ++e) { P1[e] = DPPF(t1[e], U[e], 0x111); P2[e] = DPPF(t2[e], U[e], 0x112); }
                    y[bj] = C[bj][0] * P2 + C[bj][1] * P1 + C[bj][2] * U + C[bj][3];
                    __builtin_amdgcn_sched_barrier(0);
                }
                f32x4 a;
#pragma unroll
                for (int e = 0; e < 4; e += 2) { const f32x2 gt = (f32x2){y[0][e], y[0][e + 1]}, vl = (f32x2){y[1][e], y[1][e + 1]}; const f32x2 t = gt * (-1.4426950408889634f);
                    f32x2 d; d.x = __builtin_amdgcn_exp2f(t.x); d.y = __builtin_amdgcn_exp2f(t.y); d = d + 1.0f; f32x2 r; r.x = __builtin_amdgcn_rcpf(d.x); r.y = __builtin_amdgcn_rcpf(d.y);
                    const f32x2 o2 = (gt * vl) * r; a[e] = o2.x; a[e + 1] = o2.y; }
                u32x2 w; w.x = cvt_pk_bf16(a[0], a[1]); w.y = cvt_pk_bf16(a[2], a[3]);
                if (n == 0) stash[ai][m] = w;
                else { u32x4 w16; w16.x = stash[ai][m].x; w16.y = stash[ai][m].y; w16.z = w.x; w16.w = w.y; *(u32x4*)(act + (size_t)r * 2816 + gc - 4) = w16; }
                __builtin_amdgcn_sched_barrier(0);
            }
        };
        grp(0, 0, cA);
        f32x4 cB[2][4];
#pragma unroll
        for (int bj = 0; bj < 2; ++bj) { const int c = bj * 2816 + u.pn * 128 + wc * 32 + 8 * fq + 4; cB[bj][0] = *(const f32x4*)(cw + c); cB[bj][1] = *(const f32x4*)(cw + 5632 + c); cB[bj][2] = *(const f32x4*)(cw + 2 * 5632 + c); cB[bj][3] = *(const f32x4*)(cb + c); }
        grp(0, 1, cA);
        grp(1, 0, cB);
        grp(1, 1, cB);
    }
};
template <class E, class = void> struct EpiLine { static constexpr bool value = false; };
template <class E> struct EpiLine<E, decltype((void)E::LINE)> { static constexpr bool value = E::LINE; };
template <class Epi, class Sched, bool ALIGN_EPI = false, bool SP2 = false>
__device__ __forceinline__ void gemm_phase(PG8_LAS unsigned char* lds, const Gemm g, const Sched& S, const Epi& E) {
    int tid_ = threadIdx.x; asm volatile("" : "+v"(tid_));
    const int tid = tid_, wid = __builtin_amdgcn_readfirstlane(tid >> 6), lane = tid & 63, wr = wid >> 2, wc = wid & 3, fr = lane & 15, fq = lane >> 4;
    const int K = g.K, nt = K / BK;
    unsigned voffA[2], voffB[2];
#pragma unroll
    for (int i = 0; i < 2; ++i) { int R, C; stage_rc(tid * 16 + i * 8192, R, C); const int Rb = EpiLine<Epi>::value ? (64 * (R >> 5) + perm32(R & 31)) : (Epi::PERM ? ((R & ~31) + perm32(R & 31)) : R);
        voffA[i] = (unsigned)(R * K + C) * 2u; voffB[i] = (unsigned)(Rb * K + C) * 2u; }
    const size_t kstep = (size_t)(BK * 2);
    const size_t hstep = (size_t)HALF * K * 2;
    const size_t tstep = 2 * hstep;
    const size_t hstepB = EpiLine<Epi>::value ? (size_t)32 * K * 2 : hstep;
    const unsigned ldsw = (unsigned)wid * 1024u;
    const int aoff = lds_byte(wr * 64 + fr, fq * 8), boff = lds_byte(wc * 32 + fr, fq * 8);
#define PG8_SA(b, h) (((b) * 2 + (h)) * HTB)
#define PG8_SB(b, h) ((4 + (b) * 2 + (h)) * HTB)
#define PG8_STAGE(bufoff, gbase, voff) do { _Pragma("unroll") for (int _i = 0; _i < 2; ++_i) \
        __builtin_amdgcn_global_load_lds((const unsigned*)((const char*)(gbase) + (voff)[_i]), (PG8_LAS unsigned*)(lds + (bufoff) + ldsw + _i * 8192), 16, 0, 0); } while (0)
#define PG8_LDA(dst, b, h) do { _Pragma("unroll") for (int m = 0; m < 4; ++m) _Pragma("unroll") for (int k = 0; k < 2; ++k) dst[m][k] = *(const PG8_LAS bf16x8*)(lds + PG8_SA(b, h) + aoff + m * 2048 + k * 1024); } while (0)
#define PG8_LDB(dst, b, h) do { _Pragma("unroll") for (int n = 0; n < 2; ++n) _Pragma("unroll") for (int k = 0; k < 2; ++k) dst[n][k] = *(const PG8_LAS bf16x8*)(lds + PG8_SB(b, h) + boff + n * 2048 + k * 1024); } while (0)
#define PG8_MMA(ai, bj, At, Bt) do { __builtin_amdgcn_s_setprio(1); _Pragma("unroll") for (int m = 0; m < 4; ++m) _Pragma("unroll") for (int n = 0; n < 2; ++n) _Pragma("unroll") for (int k = 0; k < 2; ++k) \
        acc[ai][bj][m][n] = __builtin_amdgcn_mfma_f32_16x16x32_bf16(Bt[n][k], At[m][k], acc[ai][bj][m][n], 0, 0, 0); __builtin_amdgcn_s_setprio(0); } while (0)
#define PG8_WAIT_V(n) asm volatile("s_waitcnt vmcnt(" #n ")" ::: "memory")
#define PG8_WAIT_L(n) asm volatile("s_waitcnt lgkmcnt(" #n ")" ::: "memory")
#define PG8_BAR __builtin_amdgcn_s_barrier()
#define PG8_SCHED __builtin_amdgcn_sched_barrier(0)
    Unit cur, nxt; int ui = 0;
    if (!S.next(0, cur)) return;
    f32x4 acc[2][2][4][2];
#pragma unroll
    for (int a = 0; a < 2; ++a)
#pragma unroll
        for (int b = 0; b < 2; ++b)
#pragma unroll
            for (int m = 0; m < 4; ++m)
#pragma unroll
                for (int n = 0; n < 2; ++n) acc[a][b][m][n] = (f32x4){0.f, 0.f, 0.f, 0.f};
    bf16x8 At[4][2], B0[2][2], B1[2][2];
    const char* cA = (const char*)g.A + (size_t)cur.pm * tstep; const char* cB = (const char*)g.Bt + (size_t)cur.pn * tstep;
    S.a_ready(cur);
    if constexpr (SP2) {
        PG8_STAGE(PG8_SB(0, 0), cB, voffB); PG8_STAGE(PG8_SB(0, 1), cB + hstepB, voffB); PG8_STAGE(PG8_SA(0, 0), cA, voffA); PG8_STAGE(PG8_SA(0, 1), cA + hstep, voffA);
        if (wr == 1) PG8_BAR;
        PG8_WAIT_V(2); PG8_BAR;
        PG8_STAGE(PG8_SB(1, 0), cB + kstep, voffB); PG8_STAGE(PG8_SA(1, 0), cA + kstep, voffA); PG8_STAGE(PG8_SB(1, 1), cB + hstepB + kstep, voffB);
        PG8_WAIT_V(6); PG8_BAR;
    } else {
        PG8_STAGE(PG8_SB(0, 0), cB, voffB); PG8_STAGE(PG8_SA(0, 0), cA, voffA); PG8_STAGE(PG8_SB(0, 1), cB + hstepB, voffB); PG8_STAGE(PG8_SA(0, 1), cA + hstep, voffA);
        if (wr == 1) PG8_BAR;
        PG8_WAIT_V(4); PG8_BAR;
        PG8_STAGE(PG8_SB(1, 0), cB + kstep, voffB); PG8_STAGE(PG8_SA(1, 0), cA + kstep, voffA); PG8_STAGE(PG8_SB(1, 1), cB + hstepB + kstep, voffB);
        PG8_WAIT_V(6); PG8_BAR;
    }
    for (;;) {
        const bool has_next = S.next(ui + 1, nxt);
        const char* nA = has_next ? (const char*)g.A + (size_t)nxt.pm * tstep : cA; const char* nB = has_next ? (const char*)g.Bt + (size_t)nxt.pn * tstep : cB;
        for (int t = 0; t < nt; t += 2) {
            const bool last = (t == nt - 2);
            const char* a1 = cA + (size_t)(t + 1) * kstep;
            const char* a2 = last ? nA : cA + (size_t)(t + 2) * kstep; const char* b2 = last ? nB : cB + (size_t)(t + 2) * kstep;
            const char* a3 = a2 + kstep; const char* b3 = b2 + kstep;
            if (last && has_next) S.a_ready(nxt);
            if constexpr (SP2) {
            PG8_LDB(B0, 0, 0); PG8_LDB(B1, 0, 1); PG8_SCHED; PG8_LDA(At, 0, 0); PG8_STAGE(PG8_SA(1, 1), a1 + hstep, voffA);
            PG8_WAIT_V(8); PG8_WAIT_L(0); PG8_BAR; PG8_MMA(0, 0, At, B0); PG8_MMA(0, 1, At, B1); PG8_BAR; PG8_SCHED;
            PG8_LDA(At, 0, 1); PG8_STAGE(PG8_SB(0, 0), b2, voffB); PG8_STAGE(PG8_SB(0, 1), b2 + hstepB, voffB); PG8_STAGE(PG8_SA(0, 0), a2, voffA);
            PG8_WAIT_V(8); PG8_WAIT_L(0); PG8_BAR; PG8_MMA(1, 0, At, B0); PG8_MMA(1, 1, At, B1); PG8_BAR; PG8_SCHED;
            PG8_LDB(B0, 1, 0); PG8_LDB(B1, 1, 1); PG8_SCHED; PG8_LDA(At, 1, 0); PG8_STAGE(PG8_SA(0, 1), a2 + hstep, voffA);
            PG8_WAIT_V(8); PG8_WAIT_L(0); PG8_BAR; PG8_MMA(0, 0, At, B0); PG8_MMA(0, 1, At, B1); PG8_BAR; PG8_SCHED;
            PG8_LDA(At, 1, 1); PG8_STAGE(PG8_SB(1, 0), b3, voffB); PG8_STAGE(PG8_SB(1, 1), b3 + hstepB, voffB); PG8_STAGE(PG8_SA(1, 0), a3, voffA);
            PG8_WAIT_V(8); PG8_WAIT_L(0); PG8_BAR; PG8_MMA(1, 0, At, B0); PG8_MMA(1, 1, At, B1); PG8_BAR; PG8_SCHED;
            } else {
            PG8_LDB(B0, 0, 0); PG8_SCHED; PG8_LDA(At, 0, 0); PG8_STAGE(PG8_SA(1, 1), a1 + hstep, voffA);
            PG8_WAIT_L(8); PG8_BAR; PG8_WAIT_L(0); PG8_MMA(0, 0, At, B0); PG8_BAR; PG8_SCHED;
            PG8_LDB(B1, 0, 1); PG8_STAGE(PG8_SB(0, 0), b2, voffB);
            PG8_BAR; PG8_WAIT_L(0); PG8_MMA(0, 1, At, B1); PG8_BAR;
            PG8_LDA(At, 0, 1); PG8_STAGE(PG8_SA(0, 0), a2, voffA);
            PG8_BAR; PG8_WAIT_L(0); PG8_MMA(1, 0, At, B0); PG8_BAR; PG8_SCHED;
            PG8_STAGE(PG8_SB(0, 1), b2 + hstepB, voffB);
            PG8_WAIT_V(6); PG8_BAR; PG8_MMA(1, 1, At, B1); PG8_BAR;
            PG8_LDB(B0, 1, 0); PG8_SCHED; PG8_LDA(At, 1, 0); PG8_STAGE(PG8_SA(0, 1), a2 + hstep, voffA);
            PG8_WAIT_L(8); PG8_BAR; PG8_WAIT_L(0); PG8_MMA(0, 0, At, B0); PG8_BAR; PG8_SCHED;
            PG8_LDB(B1, 1, 1); PG8_STAGE(PG8_SB(1, 0), b3, voffB);
            PG8_BAR; PG8_WAIT_L(0); PG8_MMA(0, 1, At, B1); PG8_BAR;
            PG8_LDA(At, 1, 1); PG8_STAGE(PG8_SA(1, 0), a3, voffA);
            PG8_BAR; PG8_WAIT_L(0); PG8_MMA(1, 0, At, B0); PG8_BAR; PG8_SCHED;
            PG8_STAGE(PG8_SB(1, 1), b3 + hstepB, voffB);
            PG8_WAIT_V(6); PG8_BAR; PG8_MMA(1, 1, At, B1); PG8_BAR;
            }
        }
        if constexpr (ALIGN_EPI) { if (wr == 0) PG8_BAR; }
        if constexpr (!Epi::AFTER_DRAIN) { E(acc, cur, wr, wc, fr, fq, lds); S.done(cur); }
        if (!has_next) break;
#pragma unroll
        for (int a = 0; a < 2; ++a)
#pragma unroll
            for (int b = 0; b < 2; ++b)
#pragma unroll
                for (int m = 0; m < 4; ++m)
#pragma unroll
                    for (int n = 0; n < 2; ++n) acc[a][b][m][n] = (f32x4){0.f, 0.f, 0.f, 0.f};
        cur = nxt; cA = nA; cB = nB; ++ui;
        if constexpr (ALIGN_EPI) { if (wr == 1) PG8_BAR; }
    }
    PG8_WAIT_V(0);
    if constexpr (!ALIGN_EPI) { if (wr == 0) PG8_BAR; }
    PG8_BAR;
    if constexpr (Epi::AFTER_DRAIN) { E.fused(acc, cur, wr, wc, fr, fq, lds, wid, lane); S.done(cur); }
#undef PG8_SA
#undef PG8_SB
#undef PG8_STAGE
#undef PG8_LDA
#undef PG8_LDB
#undef PG8_MMA
#undef PG8_WAIT_V
#undef PG8_WAIT_L
#undef PG8_BAR
#undef PG8_SCHED
}
}
constexpr int NB = 8, SEQ = 4096, MT = NB * SEQ, DM = 1024, NZ = 2048, FF = 2816, NUP = 5632, PLE = 256;
constexpr int NWAVES = 8;
constexpr size_t MiB = 1u << 20;
constexpr size_t WS_WIN = 1 * MiB, WS_WO = 5 * MiB, WS_WUP = 7 * MiB, WS_WDN = 19 * MiB, WS_WG = 25 * MiB, WS_WPLE = 27 * MiB;
constexpr size_t WS_XN = 32 * MiB;
constexpr size_t WS_PB = 96 * MiB;
constexpr size_t WS_E = 112 * MiB;
constexpr size_t WS_Z = 176 * MiB;
constexpr size_t WS_OP = 304 * MiB;
constexpr size_t WS_ML = 400 * MiB;
constexpr size_t WS_MIX = 406 * MiB;
constexpr size_t WS_HALO = 470 * MiB;
constexpr size_t WS_SS1 = 482 * MiB, WS_SS2 = WS_SS1 + (size_t)MT * 4, WS_RI = WS_SS2 + (size_t)MT * 4;
constexpr size_t WS_ACT = 176 * MiB;
constexpr size_t WS_END = 488 * MiB;
static_assert(WS_ACT + (size_t)MT * FF * 2 <= WS_MIX, "act overlay");
constexpr int LDS_BYTES = 147456;
#define LAS __attribute__((address_space(3)))
typedef unsigned short bf16;
typedef unsigned v4u __attribute__((ext_vector_type(4)));
typedef unsigned v2u __attribute__((ext_vector_type(2)));
typedef float f32x4 __attribute__((ext_vector_type(4)));
typedef float f32x16 __attribute__((ext_vector_type(16)));
typedef short bf16x8 __attribute__((ext_vector_type(8)));
#define LDS_WAIT() asm volatile("s_waitcnt lgkmcnt(0)" ::: "memory")
__device__ __forceinline__ unsigned pk2(float lo, float hi) { return pg8::cvt_pk_bf16(lo, hi); }
__device__ __forceinline__ float blo(unsigned w) { return __uint_as_float(w << 16); }
__device__ __forceinline__ float bhi(unsigned w) { return __uint_as_float(w & 0xffff0000u); }
__device__ __forceinline__ float wave_sum(float v) {
#pragma unroll
    for (int o = 1; o < 64; o <<= 1) v += __shfl_xor(v, o);
    return v;
}

__device__ __forceinline__ void tr_fill(const float* W, int ldw, int k0, int c0, const float* kscale, float mul, LAS float* scr, int lane) {
    const int c4 = (lane & 7) * 4;
    f32x4 v[8];
#pragma unroll
    for (int i = 0; i < 8; ++i) v[i] = __builtin_nontemporal_load((const f32x4*)(W + (size_t)(k0 + (lane >> 3) + 8 * i) * ldw + c0 + c4));
#pragma unroll
    for (int i = 0; i < 8; ++i) { const int kk = (lane >> 3) + 8 * i; const float sc = kscale ? kscale[k0 + kk] * mul : mul;
        scr[kk * 33 + c4 + 0] = v[i].x * sc; scr[kk * 33 + c4 + 1] = v[i].y * sc; scr[kk * 33 + c4 + 2] = v[i].z * sc; scr[kk * 33 + c4 + 3] = v[i].w * sc; }
    LDS_WAIT(); asm volatile("" ::: "memory");
}
__device__ __forceinline__ void tr_write(bf16* WT, int ldt, int row0, int kd0, LAS float* scr, int lane) {
    const int c = lane & 7;
#pragma unroll
    for (int j = 0; j < 4; ++j) { const int n = (lane >> 3) + 8 * j; const LAS float* s = scr + (8 * c) * 33 + n;
        v4u o; o.x = pk2(s[0 * 33], s[1 * 33]); o.y = pk2(s[2 * 33], s[3 * 33]); o.z = pk2(s[4 * 33], s[5 * 33]); o.w = pk2(s[6 * 33], s[7 * 33]);
        *(v4u*)(WT + (size_t)(row0 + n) * ldt + kd0 + 8 * c) = o; }
    LDS_WAIT(); asm volatile("" ::: "memory");
}
__device__ __forceinline__ void weff_item(const float* pool_w, const float* pool_scale, const float* w_out, bf16* WT, int g, int c8, int n0, int lane) {
    const int n = lane & 31, half = lane >> 5;
    float acc[4] = {0.f, 0.f, 0.f, 0.f};
    const float* pw = pool_w + ((size_t)(g * 128 + c8 * 8 + half * 4)) * 128;
    const float* wo = w_out + (size_t)(512 + g * 128) * 1024 + n0 + n;
    const float* ps = pool_scale + g * 128;
#pragma unroll 4
    for (int e = 0; e < 128; e += 4) {
        const f32x4 sc = *(const f32x4*)(ps + e);
        const float w0 = wo[(size_t)(e + 0) * 1024] * sc.x, w1 = wo[(size_t)(e + 1) * 1024] * sc.y, w2 = wo[(size_t)(e + 2) * 1024] * sc.z, w3 = wo[(size_t)(e + 3) * 1024] * sc.w;
#pragma unroll
        for (int i = 0; i < 4; ++i) { const f32x4 p = *(const f32x4*)(pw + (size_t)i * 128 + e); acc[i] += (p.x * w0 + p.y * w1) + (p.z * w2 + p.w * w3); }
    }
    v2u o; o.x = pk2(acc[0], acc[1]); o.y = pk2(acc[2], acc[3]);
    *(v2u*)(WT + (size_t)(n0 + n) * 1024 + 512 + g * 128 + c8 * 8 + half * 4) = o;
}

struct Args { const float* in[16]; float* out; unsigned char* ws; int ph_lo, ph_hi; };
typedef __attribute__((address_space(4))) const unsigned char* kptr_t;
__device__ __forceinline__ kptr_t kargs_base() { kptr_t p = (kptr_t)__builtin_amdgcn_kernarg_segment_ptr(); asm volatile("" : "+s"(p)); return p; }
__device__ __forceinline__ unsigned long long karg_u64(int off) { return *(const __attribute__((address_space(4))) unsigned long long*)(kargs_base() + off); }
#define GAS1 __attribute__((address_space(1)))
__device__ __forceinline__ const float* karg_in(int i) { return (const float*)(const GAS1 float*)karg_u64(8 * i); }
__device__ __forceinline__ float* karg_out() { return (float*)(GAS1 float*)karg_u64(128); }
__device__ __forceinline__ unsigned char* karg_ws() { return (unsigned char*)(GAS1 unsigned char*)karg_u64(136); }
__device__ __forceinline__ int karg_i32(int off) { return *(const __attribute__((address_space(4))) int*)(kargs_base() + off); }

__device__ __forceinline__ void p0_prologue(unsigned char* ws, LAS unsigned char* lds, int gw, int NGW, int gws, int lane, int wave) {
    LAS float* scr = (LAS float*)(lds + wave * 16384);
    const float* w_in = karg_in(3); const float* pool_w = karg_in(4); const float* pool_scale = karg_in(5); const float* w_out = karg_in(6); const float* ln_ffn = karg_in(7);
    const float* w_up = karg_in(8); const float* w_down = karg_in(11); const float* ln_ple = karg_in(12); const float* w_g = karg_in(13); const float* w_ple = karg_in(14);
    constexpr int I_IN = 16 * 64, I_OT = 8 * 32, I_EFF = 4 * 16 * 32, I_UP = 16 * 176, I_DN = 44 * 32, I_G = 16 * 32, I_PLE = 4 * 32;
    constexpr int NITEMS = I_IN + I_OT + I_EFF + I_UP + I_DN + I_G + I_PLE;
    for (int it = gws; it < NITEMS; it += NGW) {
        int r = it;
        if (r < I_EFF) { const int g = r >> 9, c8 = (r >> 5) & 15, nb = r & 31; weff_item(pool_w, pool_scale, w_out, (bf16*)(ws + WS_WO), g, c8, nb * 32, lane); continue; } r -= I_EFF;
        if (r < I_IN) { const int kb = r >> 6, nb = r & 63; tr_fill(w_in, NZ, kb * 64, nb * 32, karg_in(2), nb < 16 ? 0.125f * 1.4426950408889634f : 1.0f, scr, lane); tr_write((bf16*)(ws + WS_WIN), 1024, nb * 32, kb * 64, scr, lane); continue; } r -= I_IN;
        if (r < I_OT) { const int kb = r >> 5, nb = r & 31; tr_fill(w_out, 1024, kb * 64, nb * 32, nullptr, 1.0f, scr, lane); tr_write((bf16*)(ws + WS_WO), 1024, nb * 32, kb * 64, scr, lane); continue; } r -= I_OT;
        if (r < I_UP) { const int kb = r / 176, nb = r % 176; const int n0 = nb * 32, pn = n0 >> 8, bj = (n0 >> 7) & 1, j = n0 & 127;
            tr_fill(w_up, NUP, kb * 64, bj * FF + pn * 128 + j, ln_ffn, 1.0f, scr, lane); tr_write((bf16*)(ws + WS_WUP), 1024, n0, kb * 64, scr, lane); continue; } r -= I_UP;
        if (r < I_DN) { const int kb = r >> 5, nb = r & 31; tr_fill(w_down, 1024, kb * 64, nb * 32, nullptr, 1.0f, scr, lane); tr_write((bf16*)(ws + WS_WDN), FF, nb * 32, kb * 64, scr, lane); continue; } r -= I_DN;
        if (r < I_G) { const int kb = r >> 5, nb = r & 31; tr_fill(w_g, 1024, kb * 64, nb * 32, ln_ple, 1.0f, scr, lane); tr_write((bf16*)(ws + WS_WG), 1024, nb * 32, kb * 64, scr, lane); continue; } r -= I_G;
        { const int kb = r >> 5, nb = r & 31; tr_fill(w_ple, 1024, kb * 64, nb * 32, nullptr, 1.0f, scr, lane); tr_write((bf16*)(ws + WS_WPLE), PLE, nb * 32, kb * 64, scr, lane); }
    }
    { float* ssz = (float*)(ws + WS_SS1); for (int i = gw * 64 + lane; i < 2 * MT; i += NGW * 64) ssz[i] = 0.f; }
    const float* x = karg_in(0); const float* lnm = karg_in(2); bf16* XN = (bf16*)(ws + WS_XN);
    f32x4 g[4];
#pragma unroll
    for (int j = 0; j < 4; ++j) g[j] = ((const f32x4*)lnm)[lane + 64 * j];
    for (int m = gw; m < MT; m += 2 * NGW) {
        const int m2 = (m + NGW) < MT ? (m + NGW) : (MT - 1);
        const f32x4* xr = (const f32x4*)(x + (size_t)m * DM) + lane; const f32x4* xr2 = (const f32x4*)(x + (size_t)m2 * DM) + lane; f32x4 v[4], u[4]; float s = 0.f, s2 = 0.f;
#pragma unroll
        for (int j = 0; j < 4; ++j) { v[j] = __builtin_nontemporal_load(xr + 64 * j); u[j] = __builtin_nontemporal_load(xr2 + 64 * j); }
#pragma unroll
        for (int j = 0; j < 4; ++j) { s += (v[j].x * v[j].x + v[j].y * v[j].y) + (v[j].z * v[j].z + v[j].w * v[j].w); s2 += (u[j].x * u[j].x + u[j].y * u[j].y) + (u[j].z * u[j].z + u[j].w * u[j].w); }
        const float inv = 1.0f / sqrtf(wave_sum(s) * (1.0f / DM) + 1e-6f), inv2 = 1.0f / sqrtf(wave_sum(s2) * (1.0f / DM) + 1e-6f);
        if (lane == 0) { float* RI = (float*)(ws + WS_RI); RI[m] = inv; RI[m2] = inv2; }
        v2u* o8 = (v2u*)(XN + (size_t)m * DM) + lane; v2u* o82 = (v2u*)(XN + (size_t)m2 * DM) + lane;
#pragma unroll
        for (int j = 0; j < 4; ++j) { v2u w; w.x = pk2(v[j].x, v[j].y); w.y = pk2(v[j].z, v[j].w); o8[64 * j] = w;
            v2u w2; w2.x = pk2(u[j].x, u[j].y); w2.y = pk2(u[j].z, u[j].w); o82[64 * j] = w2; }
    }
    const float* p = karg_in(1); bf16* PB = (bf16*)(ws + WS_PB);
    for (int m = gw; m < MT; m += 4 * NGW) { f32x4 v[4];
#pragma unroll
        for (int j = 0; j < 4; ++j) { const int mj = (m + j * NGW) < MT ? (m + j * NGW) : (MT - 1); v[j] = __builtin_nontemporal_load((const f32x4*)(p + (size_t)mj * PLE) + lane); }
#pragma unroll
        for (int j = 0; j < 4; ++j) { v2u w; w.x = pk2(v[j].x, v[j].y); w.y = pk2(v[j].z, v[j].w); const int mj = (m + j * NGW) < MT ? (m + j * NGW) : (MT - 1); ((v2u*)(PB + (size_t)mj * PLE))[lane] = w; } }
}

__device__ __forceinline__ float other_half(float v) { const auto r = __builtin_amdgcn_permlane32_swap(__float_as_uint(v), __float_as_uint(v), false, false); const unsigned o = (__lane_id() < 32) ? r[1] : r[0]; return __uint_as_float(o); }
__device__ __forceinline__ float max_halves(float v) { const auto r = __builtin_amdgcn_permlane32_swap(__float_as_uint(v), __float_as_uint(v), false, false); return fmaxf(__uint_as_float(r[0]), __uint_as_float(r[1])); }
__device__ __forceinline__ float sum_halves(float v) { const auto r = __builtin_amdgcn_permlane32_swap(__float_as_uint(v), __float_as_uint(v), false, false); return __uint_as_float(r[0]) + __uint_as_float(r[1]); }
__device__ __forceinline__ int crow(int r, int hi) { return (r & 3) + 8 * (r >> 2) + 4 * hi; }
struct AttnIt { int p, h, lsh, r, a0; size_t tokbase; };
__device__ __forceinline__ AttnIt attn_decode(int it) {
    AttnIt A; const int bh = it / 48, rem = it % 48, j = rem & 15; A.p = rem >> 4; A.h = bh & 7; A.lsh = 2 * A.p;
    int chunk; if (A.p == 0) { A.r = 0; chunk = j; } else if (A.p == 1) { A.r = j >> 2; chunk = j & 3; } else { A.r = j; chunk = 0; }
    A.a0 = chunk * 256; A.tokbase = (size_t)(bh >> 3) * SEQ; return A;
}
__device__ __forceinline__ void attn_prefetch(const bf16* Z, const AttnIt& A, int tid, v4u (&kr)[6], v4u (&vr)[6], bf16x8 (&qf)[4]) {
    const unsigned tb = (unsigned)A.tokbase, r = (unsigned)A.r, lsh = (unsigned)A.lsh, hc = (unsigned)A.h * 64u;
#pragma unroll
    for (int i = 0; i < 6; ++i) { const int id = tid + 512 * i, key = id >> 3, pc = id & 7, a = A.a0 - 128 + key; const unsigned ac = a < 0 ? 0u : (unsigned)a;
        kr[i] = *(const v4u*)(Z + ((tb + (ac << lsh) + r) * (unsigned)NZ + 512u + hc + (unsigned)pc * 8u)); }
#pragma unroll
    for (int i = 0; i < 3; ++i) { const int id = tid + 512 * i, pc = id & 7, kp = id >> 3, a = A.a0 - 128 + 2 * kp; const unsigned ac = a < 0 ? 0u : (unsigned)a;
        vr[2 * i] = *(const v4u*)(Z + ((tb + (ac << lsh) + r) * (unsigned)NZ + 1024u + hc + (unsigned)pc * 8u)); vr[2 * i + 1] = *(const v4u*)(Z + ((tb + ((ac + 1u) << lsh) + r) * (unsigned)NZ + 1024u + hc + (unsigned)pc * 8u)); }
    const int w = tid >> 6, lane = tid & 63, q = lane & 31, hi = lane >> 5; const unsigned aq = (unsigned)(A.a0 + 32 * w + q); const unsigned tq = tb + (aq << lsh) + r;
#pragma unroll
    for (int s = 0; s < 4; ++s) qf[s] = *(const bf16x8*)(Z + (tq * (unsigned)NZ + hc + 16u * s + 8u * hi));
}
__device__ __forceinline__ void attn_stage(LAS unsigned char* lds, int tid, const v4u (&kr)[6], const v4u (&vr)[6]) {
    LAS bf16* Ks = (LAS bf16*)lds; LAS unsigned* vt32 = (LAS unsigned*)(lds + 384 * 72 * 2);
#pragma unroll
    for (int i = 0; i < 6; ++i) { const int id = tid + 512 * i, key = id >> 3, pc = id & 7; *(LAS v4u*)(Ks + key * 72 + pc * 8) = kr[i]; }
#pragma unroll
    for (int i = 0; i < 3; ++i) { const int id = tid + 512 * i, pc = id & 7, kp = id >> 3;
        const int k16 = (2 * kp) & 15, kpos = ((2 * kp) & ~15) + ((k16 < 4 || k16 >= 12) ? k16 : (k16 < 8 ? k16 + 4 : k16 - 4));
#pragma unroll
        for (int e2 = 0; e2 < 4; ++e2) { const unsigned w0 = vr[2 * i][e2], w1 = vr[2 * i + 1][e2];
            vt32[((pc * 8 + 2 * e2) * 392 + ((((kpos >> 3) ^ pc) << 3) | (kpos & 7))) >> 1] = (w0 & 0xffffu) | (w1 << 16);
            vt32[((pc * 8 + 2 * e2 + 1) * 392 + ((((kpos >> 3) ^ pc) << 3) | (kpos & 7))) >> 1] = (w0 >> 16) | (w1 & 0xffff0000u); } }
}
__device__ __forceinline__ void attn_compute(LAS unsigned char* lds, bf16* OP, float* ML, const AttnIt& A, int tid, const bf16x8 (&qf)[4]) {
    const int p = A.p, h = A.h, lsh = A.lsh;
    LAS bf16* Ks = (LAS bf16*)lds;
    LAS bf16* Vt = (LAS bf16*)(lds + 384 * 72 * 2);
    const int w = tid >> 6, lane = tid & 63, q = lane & 31, hi = lane >> 5;
    const int aq = A.a0 + 32 * w + q; const size_t tq = A.tokbase + ((size_t)aq << lsh) + A.r;
    const float slope2 = __builtin_amdgcn_exp2f(-(float)(h + 1)) * (float)(1 << lsh) * 1.4426950408889634f;
    const int dmax = aq < 128 ? aq : 128;
    const bool edge = (A.a0 + 32 * w) < 128;
    float mx = -1e30f, l = 0.f;
    f32x16 o[2];
#pragma unroll
    for (int db = 0; db < 2; ++db)
#pragma unroll
        for (int e = 0; e < 16; ++e) o[db][e] = 0.f;
#pragma unroll 1
    for (int kb = 4; kb >= 0; --kb) {
        const int dbase = 128 - 32 * kb + q - 4 * hi; const float c0 = -slope2 * (float)dbase;
        f32x16 st;
#pragma unroll
        for (int e = 0; e < 16; ++e) st[e] = c0 + slope2 * (float)((e & 3) + 8 * (e >> 2));
#pragma unroll
        for (int s = 0; s < 4; ++s) { const bf16x8 kf = *(const LAS bf16x8*)(Ks + (32 * w + 32 * kb + q) * 72 + 16 * s + 8 * hi); st = __builtin_amdgcn_mfma_f32_32x32x16_bf16(kf, qf[s], st, 0, 0, 0); }
        if (kb == 0 || kb == 4 || edge) {
#pragma unroll
            for (int e = 0; e < 16; ++e) { const int diff = dbase - ((e & 3) + 8 * (e >> 2)); st[e] = ((unsigned)diff <= (unsigned)dmax) ? st[e] : -1e30f; }
        }
        float bm = fmaxf(fmaxf(st[0], st[1]), st[2]);
#pragma unroll
        for (int e = 3; e < 15; e += 2) bm = fmaxf(fmaxf(bm, st[e]), st[e + 1]);
        bm = fmaxf(bm, st[15]);
        bm = max_halves(bm);
        const float mn = fmaxf(mx, bm);
        if (__builtin_amdgcn_ballot_w64(mn > mx)) { const float sc = __builtin_amdgcn_exp2f(mx - mn); l *= sc;
#pragma unroll
            for (int db = 0; db < 2; ++db)
#pragma unroll
                for (int e = 0; e < 16; ++e) o[db][e] *= sc; }
        mx = mn;
        float ls = 0.f;
#pragma unroll
        for (int e = 0; e < 16; ++e) { const float pv = __builtin_amdgcn_exp2f(st[e] - mn); st[e] = pv; ls += pv; }
        l += ls;
#pragma unroll
        for (int s2 = 0; s2 < 2; ++s2) {
            v4u pw; pw.x = pk2(st[8 * s2 + 0], st[8 * s2 + 1]); pw.y = pk2(st[8 * s2 + 2], st[8 * s2 + 3]); pw.z = pk2(st[8 * s2 + 4], st[8 * s2 + 5]); pw.w = pk2(st[8 * s2 + 6], st[8 * s2 + 7]);
            const bf16x8 pf = __builtin_bit_cast(bf16x8, pw);
#pragma unroll
            for (int db = 0; db < 2; ++db) { const bf16x8 vf = *(const LAS bf16x8*)(Vt + (32 * db + q) * 392 + (((4 * w + 4 * kb + 2 * s2 + hi) ^ ((4 * db + (q >> 3)) & 7)) << 3));
                o[db] = __builtin_amdgcn_mfma_f32_32x32x16_bf16(vf, pf, o[db], 0, 0, 0); } }
    }
    l = sum_halves(l);
    const float il = 1.0f / l;
    bf16* op = OP + ((size_t)p * MT + tq) * 512 + h * 64 + 8 * hi;
#pragma unroll
    for (int db = 0; db < 2; ++db)
#pragma unroll
        for (int g4 = 0; g4 < 4; g4 += 2) {
            v2u a, b; a.x = pk2(o[db][4 * g4] * il, o[db][4 * g4 + 1] * il); a.y = pk2(o[db][4 * g4 + 2] * il, o[db][4 * g4 + 3] * il);
            b.x = pk2(o[db][4 * g4 + 4] * il, o[db][4 * g4 + 5] * il); b.y = pk2(o[db][4 * g4 + 6] * il, o[db][4 * g4 + 7] * il);
            { auto r = __builtin_amdgcn_permlane32_swap(a.x, b.x, false, false); a.x = r[0]; b.x = r[1]; }
            { auto r = __builtin_amdgcn_permlane32_swap(a.y, b.y, false, false); a.y = r[0]; b.y = r[1]; }
            v4u w; w.x = a.x; w.y = a.y; w.z = b.x; w.w = b.y;
            *(v4u*)(op + 32 * db + 8 * g4) = w; }
    if (hi == 0) { float* mp = ML + (((size_t)p * MT + tq) * 8 + h) * 2; mp[0] = mx; mp[1] = l; }
}

template <int MODE  > __device__ __forceinline__ void merge_pool(const bf16* Z, const bf16* OP, const float* ML, bf16* MIX, int gtid, int nthr) {
    if (MODE == 1) {
    for (int idx0 = gtid; idx0 < MT * 64; idx0 += 2 * nthr) {
        int id[2]; id[0] = idx0; id[1] = (idx0 + nthr) < MT * 64 ? (idx0 + nthr) : idx0;
        float mm_[2][3], ll_[2][3]; v4u ov[2][3];
#pragma unroll
        for (int k = 0; k < 2; ++k) { const int tok = id[k] >> 6, hh = (id[k] >> 3) & 7, pc = id[k] & 7;
#pragma unroll
            for (int p = 0; p < 3; ++p) { const float* mp = ML + (((size_t)p * MT + tok) * 8 + hh) * 2; const v2u t = *(const v2u*)mp; mm_[k][p] = __uint_as_float(t.x); ll_[k][p] = __uint_as_float(t.y);
                ov[k][p] = __builtin_nontemporal_load((const v4u*)(OP + ((size_t)p * MT + tok) * 512 + hh * 64 + pc * 8)); } }
#pragma unroll
        for (int k = 0; k < 2; ++k) { const int tok = id[k] >> 6, hh = (id[k] >> 3) & 7, pc = id[k] & 7;
            const float mm = fmaxf(mm_[k][0], fmaxf(mm_[k][1], mm_[k][2])); float wgt[3], wsum = 0.f;
#pragma unroll
            for (int p = 0; p < 3; ++p) { wgt[p] = ll_[k][p] * __builtin_amdgcn_exp2f(mm_[k][p] - mm); wsum += wgt[p]; }
            const float iw = 1.0f / wsum; float acc[8];
#pragma unroll
            for (int e = 0; e < 8; ++e) acc[e] = 0.f;
#pragma unroll
            for (int p = 0; p < 3; ++p) { const float wp = wgt[p] * iw;
#pragma unroll
                for (int e2 = 0; e2 < 4; ++e2) { acc[2 * e2] += wp * blo(ov[k][p][e2]); acc[2 * e2 + 1] += wp * bhi(ov[k][p][e2]); } }
            v4u o; o.x = pk2(acc[0], acc[1]); o.y = pk2(acc[2], acc[3]); o.z = pk2(acc[4], acc[5]); o.w = pk2(acc[6], acc[7]);
            *(v4u*)(MIX + (size_t)tok * 1024 + hh * 64 + pc * 8) = o; }
    }
    }
    if (MODE == 2) {
#pragma unroll 2
    for (int idx = gtid; idx < (MT / 8) * 64; idx += nthr) {
        const int tg = idx >> 6, cb = idx & 63, g = cb >> 4, wdw = 2 << g, tok0 = tg * 8, t0 = tok0 & (SEQ - 1);
        const bf16* up = Z + (size_t)tok0 * NZ + 1536 + cb * 8;
        float sum[8];
#pragma unroll
        for (int e = 0; e < 8; ++e) sum[e] = 0.f;
        const int back = (wdw - 1) < t0 ? (wdw - 1) : t0;
        for (int i = 1; i <= back; ++i) { const v4u v = *(const v4u*)(up - (size_t)i * NZ);
#pragma unroll
            for (int e2 = 0; e2 < 4; ++e2) { sum[2 * e2] += blo(v[e2]); sum[2 * e2 + 1] += bhi(v[e2]); } }
        v4u cur[8];
#pragma unroll
        for (int jj = 0; jj < 8; ++jj) cur[jj] = *(const v4u*)(up + (size_t)jj * NZ);
#pragma unroll
        for (int jj = 0; jj < 8; ++jj) {
#pragma unroll
            for (int e2 = 0; e2 < 4; ++e2) { sum[2 * e2] += blo(cur[jj][e2]); sum[2 * e2 + 1] += bhi(cur[jj][e2]); }
            const int t = t0 + jj; const int cnt = (t + 1) < wdw ? (t + 1) : wdw; const float ic = 1.0f / (float)cnt;
            v4u o; o.x = pk2(sum[0] * ic - blo(cur[jj].x), sum[1] * ic - bhi(cur[jj].x)); o.y = pk2(sum[2] * ic - blo(cur[jj].y), sum[3] * ic - bhi(cur[jj].y));
            o.z = pk2(sum[4] * ic - blo(cur[jj].z), sum[5] * ic - bhi(cur[jj].z)); o.w = pk2(sum[6] * ic - blo(cur[jj].w), sum[7] * ic - bhi(cur[jj].w));
            *(v4u*)(MIX + (size_t)(tok0 + jj) * 1024 + 512 + cb * 8) = o;
            const int tout = t + 1 - wdw;
            if (jj < 7 && tout >= 0) { const v4u v = *(const v4u*)(up + ((ptrdiff_t)(jj + 1) - wdw) * NZ);
#pragma unroll
                for (int e2 = 0; e2 < 4; ++e2) { sum[2 * e2] -= blo(v[e2]); sum[2 * e2 + 1] -= bhi(v[e2]); } }
        }
    }
    }
}

__device__ __forceinline__ void conv_fixup_panel(const float* halo, const float* cw, const float* cb, bf16* act, int pm, int tid) {
    if ((pm & 15) == 0) return;
    for (int idx = tid; idx < 2 * (FF / 4); idx += NWAVES * 64) {
        const int rs = idx / (FF / 4), gc = (idx % (FF / 4)) * 4, pn = gc >> 7, j = gc & 127;
        f32x4 y[2];
#pragma unroll
        for (int bj = 0; bj < 2; ++bj) { const int c = bj * FF + gc;
#define HAL(pm_, rsel_) (*(const f32x4*)(halo + ((size_t)((pm_) * 4 + (rsel_)) * 22 + pn) * 256 + bj * 128 + j))
            f32x4 u0, um1, um2;
            if (rs == 0) { u0 = HAL(pm, 0); um1 = HAL(pm - 1, 3); um2 = HAL(pm - 1, 2); } else { u0 = HAL(pm, 1); um1 = HAL(pm, 0); um2 = HAL(pm - 1, 3); }
#undef HAL
            y[bj] = *(const f32x4*)(cw + c) * um2 + *(const f32x4*)(cw + NUP + c) * um1 + *(const f32x4*)(cw + 2 * NUP + c) * u0 + *(const f32x4*)(cb + c); }
        f32x4 a;
#pragma unroll
        for (int e2 = 0; e2 < 4; ++e2) a[e2] = y[0][e2] * pg8::sigmoidf_(y[0][e2]) * y[1][e2];
        v2u w; w.x = pk2(a[0], a[1]); w.y = pk2(a[2], a[3]);
        *(v2u*)(act + (size_t)(pm * 256 + rs) * FF + gc) = w;
    }
}

#define XB_TMO      128
#define XB_XCNT(j)  (256  + 64 * (j))
#define XB_XSUB(j)  (1280 + 64 * (j))
#define XB_XGEN(j)  (2304 + 64 * (j))
#define XB_TOP      3328
#define XB_TOPGEN   3392
#define XCD_BAR_WORDS 3456
#define XB_SPIN_CAP (1u << 18)

__device__ __forceinline__ unsigned xb_ld(unsigned* p)              { return __hip_atomic_load(p, __ATOMIC_RELAXED, __HIP_MEMORY_SCOPE_AGENT); }
__device__ __forceinline__ unsigned xb_add(unsigned* p, unsigned v) { return __hip_atomic_fetch_add(p, v, __ATOMIC_RELAXED, __HIP_MEMORY_SCOPE_AGENT); }
__device__ __forceinline__ unsigned xb_xcc_id() { return (unsigned)__builtin_amdgcn_s_getreg((3 << 11) | 20) & 0xFu; }
#define XB_SPIN(cond, bar) do { unsigned _sp = 0; while (cond) { __builtin_amdgcn_s_sleep(1); \
    if ((++_sp & 255u) == 0u) { if (xb_ld(&(bar)[XB_TMO])) break; if (_sp > XB_SPIN_CAP) { atomicAdd(&(bar)[XB_TMO], 1u); break; } } } } while (0)

struct XcdBarrier {
    unsigned* bar; unsigned x;
    volatile LAS unsigned* st;
};

__device__ __forceinline__ XcdBarrier xcd_barrier_post(unsigned* bar, volatile LAS unsigned* st) {
    XcdBarrier b; b.bar = bar; b.x = xb_xcc_id(); b.st = st;
    if (threadIdx.x == 0) (void)xb_add(&bar[XB_XCNT(b.x)], 1u);
    return b;
}
__device__ __forceinline__ void xcd_barrier_complete(unsigned* bar, unsigned x, unsigned& nloc, unsigned& nx) {
    const unsigned G = gridDim.x * gridDim.y * gridDim.z;
    unsigned sum, cnt, mine, sp = 0u;
    for (;;) {
        sum = 0u; cnt = 0u; mine = 0u;
#pragma unroll
        for (unsigned j = 0; j < 16; ++j) { const unsigned c = xb_ld(&bar[XB_XCNT(j)]); sum += c; cnt += (c > 0u) ? 1u : 0u; mine = (j == x) ? c : mine; }
        if (sum == G) break;
        __builtin_amdgcn_s_sleep(1);
        if ((++sp & 255u) == 0u) { if (xb_ld(&bar[XB_TMO])) break; if (sp > XB_SPIN_CAP) { atomicAdd(&bar[XB_TMO], 1u); break; } }
    }
    nloc = mine > 0u ? mine : 1u; nx = cnt > 0u ? cnt : 1u;
}

__device__ __forceinline__ void xcd_barrier(const XcdBarrier& b) {
    asm volatile("s_waitcnt vmcnt(0)" ::: "memory");
    __syncthreads();
    if (threadIdx.x == 0) {
        unsigned* bar = b.bar;
        __builtin_amdgcn_s_waitcnt(0);
        unsigned nloc = b.st[0], nx = b.st[1];
        if (nloc == 0u) { xcd_barrier_complete(bar, b.x, nloc, nx); b.st[0] = nloc; b.st[1] = nx; }
        const unsigned old = xb_add(&bar[XB_XSUB(b.x)], 1u);
        const unsigned gen = old / nloc;
        if (old + 1u == (gen + 1u) * nloc) {
            __builtin_amdgcn_fence(__ATOMIC_RELEASE, "agent");
            asm volatile("s_waitcnt vmcnt(0)" ::: "memory");
            const unsigned og = xb_add(&bar[XB_TOP], 1u);
            const unsigned tg = og / nx;
            if (og + 1u == (tg + 1u) * nx) xb_add(&bar[XB_TOPGEN], 1u);
            else XB_SPIN(xb_ld(&bar[XB_TOPGEN]) == tg, bar);
            __builtin_amdgcn_fence(__ATOMIC_ACQUIRE, "agent");
            xb_add(&bar[XB_XGEN(b.x)], 1u);
            asm volatile("s_waitcnt vmcnt(0)" ::: "memory");
        } else {
            XB_SPIN(xb_ld(&bar[XB_XGEN(b.x)]) == gen, bar);
            __builtin_amdgcn_fence(__ATOMIC_ACQUIRE, "agent");
            asm volatile("s_waitcnt vmcnt(0)" ::: "memory");
        }
    }
    __syncthreads();
}


__device__ __forceinline__ void atomic_grid_barrier(unsigned* ctr, unsigned nblocks) {
    asm volatile("s_waitcnt vmcnt(0)" ::: "memory");
    __syncthreads();
    if (threadIdx.x == 0) {
        __builtin_amdgcn_fence(__ATOMIC_RELEASE, "agent");
        asm volatile("s_waitcnt vmcnt(0)" ::: "memory");
        __hip_atomic_fetch_add(ctr, 1u, __ATOMIC_RELAXED, __HIP_MEMORY_SCOPE_AGENT);
        while (__hip_atomic_load(ctr, __ATOMIC_RELAXED, __HIP_MEMORY_SCOPE_AGENT) < nblocks) __builtin_amdgcn_s_sleep(2);
        __builtin_amdgcn_fence(__ATOMIC_ACQUIRE, "agent");
        asm volatile("s_waitcnt vmcnt(0)" ::: "memory");
    }
    __syncthreads();
}


constexpr int NPH = 10;
#ifndef REPS
#define REPS {1,1,1,1,1,1,1,1,1,1}
#endif
__device__ constexpr int kReps[10] = REPS;
__global__ void __launch_bounds__(NWAVES * 64, 2) hybrid_fwd(Args args) {
    extern __shared__ __attribute__((aligned(16))) unsigned char lds_raw[];
    LAS unsigned char* lds = (LAS unsigned char*)lds_raw;
    cg::grid_group grid = cg::this_grid();
    if (threadIdx.x < 2) ((LAS unsigned*)(lds + 131072 + 8192))[threadIdx.x] = 0u;
    __syncthreads();
    const int tid = threadIdx.x, lane = tid & 63, wave = __builtin_amdgcn_readfirstlane(tid >> 6);
    const int G = gridDim.x, bx = blockIdx.x;
    const int gw = bx * NWAVES + wave, NGW = G * NWAVES, gws = wave * G + bx;
    const int gtid = bx * (NWAVES * 64) + tid, nthr = G * NWAVES * 64;
    unsigned char* ws = karg_ws();
    bf16* XN = (bf16*)(ws + WS_XN); bf16* PB = (bf16*)(ws + WS_PB); bf16* EB = (bf16*)(ws + WS_E); bf16* Z = (bf16*)(ws + WS_Z);
    bf16* OP = (bf16*)(ws + WS_OP); float* ML = (float*)(ws + WS_ML); bf16* MIX = (bf16*)(ws + WS_MIX); float* HALO = (float*)(ws + WS_HALO);
    float* SS1 = (float*)(ws + WS_SS1); float* SS2 = (float*)(ws + WS_SS2); bf16* ACT = (bf16*)(ws + WS_ACT);
    const int lo = karg_i32(144), hi = karg_i32(148);
    XcdBarrier xbar = xcd_barrier_post((unsigned*)ws + 1024, (volatile LAS unsigned*)(lds + 131072 + 8192));
    if (lo > hi) grid.sync();
#ifndef PHMASK
#define PHMASK 0x3ff
#endif
#define IN(k) (((PHMASK >> (k)) & 1) && lo <= (k) && (k) < hi)
#define SEAM(k) do { if (IN(k) && IN((k) + 1)) xcd_barrier(xbar); } while (0)

    if (IN(0)) for (int rep_ = 0; rep_ < kReps[0]; ++rep_) { p0_prologue(ws, lds, gw, NGW, gws, lane, wave); }
    SEAM(0);
    if (IN(1)) for (int rep_ = 0; rep_ < kReps[1]; ++rep_) {
        { pg8::Gemm g{XN, (const bf16*)(ws + WS_WIN), MT, NZ, DM}; pg8::StaticOrder S; S.init(MT, NZ, G, bx); pg8::EpiStoreBf16T<true> E{Z, NZ, (const float*)(ws + WS_RI)};
          pg8::gemm_phase<pg8::EpiStoreBf16T<true>, pg8::StaticOrder, true, true>(lds, g, S, E); }
    }
    SEAM(1);
    if (IN(2)) for (int rep_ = 0; rep_ < kReps[2]; ++rep_) {
        v4u kr[6], vr[6]; bf16x8 qn[4]; int it = bx;
        AttnIt An = attn_decode(it); attn_prefetch(Z, An, tid, kr, vr, qn);
        merge_pool<2>(Z, OP, ML, MIX, gtid, nthr);
#pragma unroll 1
        for (; it < 64 * 48; it += G) {
            const AttnIt Ac = An; bf16x8 qc[4];
#pragma unroll
            for (int s = 0; s < 4; ++s) qc[s] = qn[s];
            attn_stage(lds, tid, kr, vr);
            __syncthreads();
            if (it + G < 64 * 48) { An = attn_decode(it + G); attn_prefetch(Z, An, tid, kr, vr, qn); }
            attn_compute(lds, OP, ML, Ac, tid, qc);
            __syncthreads();
        }
    }
    SEAM(2);
    if (IN(3)) for (int rep_ = 0; rep_ < kReps[3]; ++rep_) { merge_pool<1>(Z, OP, ML, MIX, gtid, nthr); }
    SEAM(3);
    if (IN(4)) for (int rep_ = 0; rep_ < kReps[4]; ++rep_) {
        pg8::Gemm g{MIX, (const bf16*)(ws + WS_WO), MT, DM, DM}; pg8::StaticOrder S; S.init(MT, DM, G, bx); pg8::EpiRes<false> E{nullptr, XN, SS1};
        pg8::gemm_phase<pg8::EpiRes<false>, pg8::StaticOrder, true, true>(lds, g, S, E);
    }
    SEAM(4);
    if (IN(5)) for (int rep_ = 0; rep_ < kReps[5]; ++rep_) {
        pg8::Gemm g{XN, (const bf16*)(ws + WS_WUP), MT, NUP, DM}; pg8::StaticOrder S; S.init(MT, NUP, G, bx); pg8::EpiConv E{SS1, karg_in(9), karg_in(10), ACT, HALO};
        pg8::gemm_phase<pg8::EpiConv, pg8::StaticOrder, true, true>(lds, g, S, E);
    }
    SEAM(5);
    if (IN(7)) {
        { const int t7 = (int)__builtin_amdgcn_mbcnt_hi(~0u, __builtin_amdgcn_mbcnt_lo(~0u, 0u)) + 64 * __builtin_amdgcn_readfirstlane((int)threadIdx.x >> 6);
          pg8::StaticOrder S0; S0.init(MT, DM, G, bx); pg8::Unit u0; const float* cwp = karg_in(9); const float* cbp = karg_in(10);
          for (int i = 0; S0.next(i, u0); ++i) conv_fixup_panel(HALO, cwp, cbp, ACT, u0.pm, t7);
          asm volatile("s_waitcnt vmcnt(0)" ::: "memory"); __syncthreads();
          if (threadIdx.x == 0) { __builtin_amdgcn_fence(__ATOMIC_ACQUIRE, "agent"); asm volatile("s_waitcnt vmcnt(0)" ::: "memory"); }
          __syncthreads(); }
#ifdef PROBE_P7
        { pg8::Gemm g{ACT, (const bf16*)(ws + WS_WDN), MT, DM, FF}; pg8::StaticOrder S; S.init(MT, DM, G, bx); pg8::EpiStoreBf16 E{MIX, DM, nullptr}; pg8::gemm_phase<pg8::EpiStoreBf16, pg8::StaticOrder, true, true>(lds, g, S, E); }
#endif
        pg8::Gemm g{ACT, (const bf16*)(ws + WS_WDN), MT, DM, FF}; pg8::StaticOrder S; S.init(MT, DM, G, bx); pg8::EpiRes<false> E{nullptr, XN, SS2};
        pg8::gemm_phase<pg8::EpiRes<false>, pg8::StaticOrder, true, true>(lds, g, S, E);
        { pg8::Gemm g{PB, (const bf16*)(ws + WS_WPLE), MT, DM, PLE}; pg8::StaticOrder S; S.init(MT, DM, G, bx); pg8::EpiStoreBf16 E{EB, DM, nullptr};
          pg8::gemm_phase<pg8::EpiStoreBf16, pg8::StaticOrder, true, true>(lds, g, S, E); }
    }
    SEAM(7);
    if (IN(8)) for (int rep_ = 0; rep_ < kReps[8]; ++rep_) {
        pg8::Gemm g{XN, (const bf16*)(ws + WS_WG), MT, DM, DM}; pg8::StaticOrder S; S.init(MT, DM, G, bx); pg8::EpiGate E{SS2, EB, XN, MIX};
        pg8::gemm_phase<pg8::EpiGate, pg8::StaticOrder, true, true>(lds, g, S, E);
    }
    SEAM(8);
    if (IN(9)) for (int rep_ = 0; rep_ < kReps[9]; ++rep_) {
        const int lane9 = (int)__builtin_amdgcn_mbcnt_hi(~0u, __builtin_amdgcn_mbcnt_lo(~0u, 0u)); const int gw9 = bx * NWAVES + __builtin_amdgcn_readfirstlane((int)threadIdx.x >> 6);
        const float* lnf = karg_in(15); float* outp = karg_out(); f32x4 g[4];
#pragma unroll
        for (int j = 0; j < 4; ++j) g[j] = ((const f32x4*)lnf)[lane9 + 64 * j];
        for (int m = gw9; m < MT; m += 2 * NGW) {
            const int m2 = (m + NGW) < MT ? (m + NGW) : (MT - 1);
            const v2u* hr = (const v2u*)(MIX + (size_t)m * DM) + lane9; const v2u* hr2 = (const v2u*)(MIX + (size_t)m2 * DM) + lane9; v2u a[4], b[4];
#pragma unroll
            for (int j = 0; j < 4; ++j) { a[j] = __builtin_nontemporal_load(hr + 64 * j); b[j] = __builtin_nontemporal_load(hr2 + 64 * j); }
            f32x4 v[4], u[4]; float s = 0.f, s2 = 0.f;
#pragma unroll
            for (int j = 0; j < 4; ++j) { v[j] = (f32x4){blo(a[j].x), bhi(a[j].x), blo(a[j].y), bhi(a[j].y)}; u[j] = (f32x4){blo(b[j].x), bhi(b[j].x), blo(b[j].y), bhi(b[j].y)};
                s += (v[j].x * v[j].x + v[j].y * v[j].y) + (v[j].z * v[j].z + v[j].w * v[j].w); s2 += (u[j].x * u[j].x + u[j].y * u[j].y) + (u[j].z * u[j].z + u[j].w * u[j].w); }
            const float inv = 1.0f / sqrtf(wave_sum(s) * (1.0f / DM) + 1e-6f), inv2 = 1.0f / sqrtf(wave_sum(s2) * (1.0f / DM) + 1e-6f);
            f32x4* xr = (f32x4*)(outp + (size_t)m * DM) + lane9; f32x4* xr2 = (f32x4*)(outp + (size_t)m2 * DM) + lane9;
#pragma unroll
            for (int j = 0; j < 4; ++j) { __builtin_nontemporal_store(v[j] * inv * g[j], xr + 64 * j); __builtin_nontemporal_store(u[j] * inv2 * g[j], xr2 + 64 * j); }
        }
    }
#undef IN
#undef SEAM
}

#ifndef N_LAUNCHES
#define N_LAUNCHES 1
#endif
extern "C" void kernel_launch(void* const* d_in, const int* in_sizes, int n_in, void* d_out, int out_size, void* d_ws, size_t ws_size, hipStream_t stream) {
    static int grid = 0;
    if (grid == 0) {
        if (n_in != 16 || out_size != MT * DM || ws_size < WS_END) { fprintf(stderr, "kernel_launch: unexpected shapes (n_in %d out %d ws %zu)\n", n_in, out_size, ws_size); grid = -1; return; }
        int dev = 0, cus = 0, per_cu = 0;
        hipGetDevice(&dev); hipDeviceGetAttribute(&cus, hipDeviceAttributeMultiprocessorCount, dev);
        if (hipFuncSetAttribute((const void*)hybrid_fwd, hipFuncAttributeMaxDynamicSharedMemorySize, LDS_BYTES) != hipSuccess) { fprintf(stderr, "kernel_launch: hipFuncSetAttribute failed\n"); grid = -1; return; }
        if (hipOccupancyMaxActiveBlocksPerMultiprocessor(&per_cu, (const void*)hybrid_fwd, NWAVES * 64, LDS_BYTES) != hipSuccess || per_cu < 1) { fprintf(stderr, "kernel_launch: occupancy query says %d\n", per_cu); per_cu = 1; }
        (void)hipGetLastError();
        grid = cus * (per_cu > 1 ? 1 : per_cu);
    }
    if (grid < 0) return;
    if (hipMemsetAsync(d_ws, 0, 32768, stream) != hipSuccess) { fprintf(stderr, "kernel_launch: memset failed\n"); return; }
    Args a{};
    for (int i = 0; i < 16; ++i) a.in[i] = (const float*)d_in[i];
    a.out = (float*)d_out; a.ws = (unsigned char*)d_ws;
    if (N_LAUNCHES == 1) {
        a.ph_lo = 0; a.ph_hi = NPH;
        void* kargs[] = {&a};
        hipError_t e = hipLaunchCooperativeKernel((const void*)hybrid_fwd, dim3(grid), dim3(NWAVES * 64), kargs, LDS_BYTES, stream);
        if (e != hipSuccess) fprintf(stderr, "cooperative launch failed: %s (grid %d)\n", hipGetErrorString(e), grid);
    } else {
        for (int k = 0; k < NPH; ++k) { a.ph_lo = k; a.ph_hi = k + 1; hipLaunchKernelGGL(hybrid_fwd, dim3(grid), dim3(NWAVES * 64), LDS_BYTES, stream, a); }
    }
}
```
